# Optimizing an MI355X kernel written in HIP

```python
import jax, jax.numpy as jnp
from jax import lax
import numpy as np

D_MODEL = 1024
BATCH = 8
SEQ = 2048
DEPTH = 4

FOX_HEAD_DIM = 64
FOX_WIDTH = D_MODEL // 2
N_FOX_HEADS = FOX_WIDTH // FOX_HEAD_DIM
CONV_WIDTH = D_MODEL // 2
CONV_KERNEL = 3
N_MEM_HEADS = 4
MEM_HEAD_DIM = 128
MEM_WIDTH = N_MEM_HEADS * MEM_HEAD_DIM
MEM_TOKENS = 256
D_FF = -(-(8 * D_MODEL) // (3 * 256)) * 256
Q_BLOCK = 128
EPS = 1e-6
IN_SPLITS = (FOX_WIDTH, FOX_WIDTH, FOX_WIDTH, N_FOX_HEADS, CONV_WIDTH, CONV_WIDTH, CONV_WIDTH, D_MODEL, D_MODEL)
IN_WIDTH = sum(IN_SPLITS)

kernel_name = "fox_shortconv_gated_hybrid"


def rmsnorm(x, g):
    xf = x.astype(jnp.float32)
    y = xf * lax.rsqrt(jnp.mean(xf * xf, axis=-1, keepdims=True) + EPS)
    return (y * g.astype(jnp.float32)).astype(x.dtype)


def split_cols(p, sizes):
    out, start = [], 0
    for s in sizes:
        out.append(p[..., start:start + s])
        start += s
    return out


def forgetting_attention(q, k, v, log_f):
    b, t, h, hd = q.shape
    q = q.transpose(0, 2, 1, 3)
    k = k.transpose(0, 2, 1, 3)
    v = v.transpose(0, 2, 1, 3)
    c = jnp.cumsum(log_f, axis=1).transpose(0, 2, 1)
    scale = hd ** -0.5
    outs = []
    for i in range(t // Q_BLOCK):
        qs, ke = i * Q_BLOCK, (i + 1) * Q_BLOCK
        s = jnp.einsum('bhqd,bhkd->bhqk', q[:, :, qs:ke], k[:, :, :ke],
                       preferred_element_type=jnp.float32) * scale
        s = s + (c[:, :, qs:ke, None] - c[:, :, None, :ke])
        mask = (qs + jnp.arange(Q_BLOCK))[:, None] >= jnp.arange(ke)[None, :]
        p = jax.nn.softmax(jnp.where(mask, s, -jnp.inf), axis=-1).astype(v.dtype)
        outs.append(jnp.einsum('bhqk,bhkd->bhqd', p, v[:, :, :ke]))
    o = jnp.concatenate(outs, axis=2)
    return o.transpose(0, 2, 1, 3).reshape(b, t, h * hd)


def causal_depthwise_conv(z, w):
    ch = z.shape[-1]
    return lax.conv_general_dilated(
        z, w.astype(z.dtype)[:, None, :], window_strides=(1,),
        padding=[(CONV_KERNEL - 1, 0)], dimension_numbers=('NWC', 'WIO', 'NWC'),
        feature_group_count=ch)


def hybrid_mixer(u, w_in, b_f, q_gain, k_gain, conv_w, w_up_a, w_up_b, w_o):
    b, t, _ = u.shape
    p = u @ w_in
    q, k, v, f_logit, z, gate_b_in, gate_c_in, g_a, g_b = split_cols(p, IN_SPLITS)
    q = rmsnorm(q.reshape(b, t, N_FOX_HEADS, FOX_HEAD_DIM), q_gain)
    k = rmsnorm(k.reshape(b, t, N_FOX_HEADS, FOX_HEAD_DIM), k_gain)
    v = v.reshape(b, t, N_FOX_HEADS, FOX_HEAD_DIM)
    log_f = jax.nn.log_sigmoid(f_logit.astype(jnp.float32) + b_f.astype(jnp.float32))
    a_out = forgetting_attention(q, k, v, log_f)
    c_out = gate_b_in * causal_depthwise_conv(gate_c_in * z, conv_w)
    merged = jax.nn.sigmoid(g_a) * (a_out @ w_up_a) + jax.nn.sigmoid(g_b) * (c_out @ w_up_b)
    return merged @ w_o


def memory_attention(u, mem_n, w_cq, w_ckv, cq_gain, ck_gain, w_co):
    b, t, _ = u.shape
    m = mem_n.shape[1]
    q = rmsnorm((u @ w_cq).reshape(b, t, N_MEM_HEADS, MEM_HEAD_DIM), cq_gain)
    kv = mem_n @ w_ckv
    k = rmsnorm(kv[..., :MEM_WIDTH].reshape(b, m, N_MEM_HEADS, MEM_HEAD_DIM), ck_gain)
    v = kv[..., MEM_WIDTH:].reshape(b, m, N_MEM_HEADS, MEM_HEAD_DIM)
    s = jnp.einsum('bthd,bmhd->bhtm', q, k, preferred_element_type=jnp.float32) * (MEM_HEAD_DIM ** -0.5)
    p = jax.nn.softmax(s, axis=-1).astype(v.dtype)
    o = jnp.einsum('bhtm,bmhd->bthd', p, v).reshape(b, t, MEM_WIDTH)
    return o @ w_co


def swiglu(u, w_gu, w_down):
    gu = u @ w_gu
    return (jax.nn.silu(gu[..., :D_FF]) * gu[..., D_FF:]) @ w_down


def setup_inputs(seed: int = 0) -> dict:
    key = jax.random.key(seed)
    ks = jax.random.split(key, 24)
    L, D = DEPTH, D_MODEL

    def w(k, shape, fan_in):
        return jax.random.normal(k, shape, jnp.float32) * (fan_in ** -0.5)

    def gain(k, shape):
        return 1.0 + 0.05 * jax.random.normal(k, shape, jnp.float32)

    return {
        "x": jax.random.normal(ks[0], (BATCH, SEQ, D), jnp.float32),
        "mem": jax.random.normal(ks[1], (BATCH, MEM_TOKENS, D), jnp.float32),
        "norm_mix": gain(ks[2], (L, D)),
        "w_in": w(ks[3], (L, D, IN_WIDTH), D),
        "b_f": 2.0 + 0.5 * jax.random.normal(ks[4], (L, N_FOX_HEADS), jnp.float32),
        "q_gain": gain(ks[5], (L, FOX_HEAD_DIM)),
        "k_gain": gain(ks[6], (L, FOX_HEAD_DIM)),
        "conv_w": w(ks[7], (L, CONV_KERNEL, CONV_WIDTH), CONV_KERNEL),
        "w_up_a": w(ks[8], (L, FOX_WIDTH, D), FOX_WIDTH),
        "w_up_b": w(ks[9], (L, CONV_WIDTH, D), CONV_WIDTH),
        "w_o": w(ks[10], (L, D, D), 2 * D),
        "norm_mem_q": gain(ks[11], (L, D)),
        "norm_mem_kv": gain(ks[12], (L, D)),
        "w_cq": w(ks[13], (L, D, MEM_WIDTH), D),
        "w_ckv": w(ks[14], (L, D, 2 * MEM_WIDTH), D),
        "cq_gain": gain(ks[15], (L, MEM_HEAD_DIM)),
        "ck_gain": gain(ks[16], (L, MEM_HEAD_DIM)),
        "w_co": w(ks[17], (L, MEM_WIDTH, D), MEM_WIDTH),
        "norm_ffn": gain(ks[18], (L, D)),
        "w_gu": w(ks[19], (L, D, 2 * D_FF), D),
        "w_down": w(ks[20], (L, D_FF, D), D_FF),
    }


def reference(x, mem, norm_mix, w_in, b_f, q_gain, k_gain, conv_w, w_up_a, w_up_b, w_o,
              norm_mem_q, norm_mem_kv, w_cq, w_ckv, cq_gain, ck_gain, w_co,
              norm_ffn, w_gu, w_down):
    h = x
    for l in range(DEPTH):
        h = h + hybrid_mixer(rmsnorm(h, norm_mix[l]), w_in[l], b_f[l], q_gain[l], k_gain[l],
                             conv_w[l], w_up_a[l], w_up_b[l], w_o[l])
        h = h + memory_attention(rmsnorm(h, norm_mem_q[l]), rmsnorm(mem, norm_mem_kv[l]),
                                 w_cq[l], w_ckv[l], cq_gain[l], ck_gain[l], w_co[l])
        h = h + swiglu(rmsnorm(h, norm_ffn[l]), w_gu[l], w_down[l])
    return h
```

```cpp
#include <hip/hip_runtime.h>
#include <hip/hip_cooperative_groups.h>
#include <cstdio>
#include <cstdint>
namespace cg = cooperative_groups;
namespace pg8 {
#define PG8_LAS __attribute__((address_space(3)))
typedef unsigned short bf16_t;
typedef short bf16x8 __attribute__((ext_vector_type(8)));
typedef float f32x4 __attribute__((ext_vector_type(4)));
typedef unsigned u32x4 __attribute__((ext_vector_type(4)));
constexpr int BM = 256, BK = 64, HALF = 128, HTB = HALF * BK * 2  , STAGE_BYTES = 8 * HTB, NXCD = 8, WGM = 8;

__host__ __device__ __forceinline__ int lds_byte(int r, int c) { const int st = (r >> 4) * 2 + (c >> 5), rr = r & 15, cc = c & 31, ob = rr * 64 + cc * 2; return st * 1024 + (ob ^ (((ob >> 9) & 1) << 5)); }
__host__ __device__ __forceinline__ void stage_rc(int b, int& R, int& C) { const int st = b / 1024, sb = b % 1024, swz = sb ^ (((sb >> 9) & 1) << 5); R = (st >> 1) * 16 + swz / 64; C = (st & 1) * 32 + (swz % 64) / 2; }
__host__ __device__ __forceinline__ int perm32(int rho) { const int n = rho >> 4, i = rho & 15; return 8 * (i >> 2) + 4 * n + (i & 3); }

struct Unit { int pm, pn; };
struct Gemm { const bf16_t* A; const bf16_t* Bt; int M, N, K; };

struct StaticOrder {
    int nM, nN, nwg, G, c;
    __host__ __device__ void init(int M, int N, int G_, int c_) { nM = M / BM; nN = N / BM; nwg = nM * nN; G = G_; c = c_; }
    __host__ __device__ bool next(int i, Unit& u) const {
        const long L = (long)i * G + c; if (L >= nwg) return false;
        int wgid = (int)L; { const int q = nwg / NXCD, r = nwg % NXCD, xcd = wgid % NXCD, off = wgid / NXCD; wgid = (xcd < r ? xcd * (q + 1) : r * (q + 1) + (xcd - r) * q) + off; }
        const int nig = WGM * nN, gid = wgid / nig, fm = gid * WGM, gsz = (nM - fm) < WGM ? (nM - fm) : WGM;
        u.pm = fm + ((wgid % nig) % gsz); u.pn = (wgid % nig) / gsz; return true;
    }
    __device__ __forceinline__ void a_ready(const Unit&) const {}
    __device__ __forceinline__ void done(const Unit&) const {}
};

__device__ __forceinline__ unsigned cvt_pk_bf16(float lo, float hi) { unsigned r; asm volatile("v_cvt_pk_bf16_f32 %0, %1, %2" : "=v"(r) : "v"(lo), "v"(hi)); return r; }
__device__ __forceinline__ float bf_lo(unsigned w) { return __uint_as_float(w << 16); }
__device__ __forceinline__ float bf_hi(unsigned w) { return __uint_as_float(w & 0xffff0000u); }
__device__ __forceinline__ u32x4 pack8(const f32x4 v0, const f32x4 v1) { u32x4 w; w.x = cvt_pk_bf16(v0[0], v0[1]); w.y = cvt_pk_bf16(v0[2], v0[3]); w.z = cvt_pk_bf16(v1[0], v1[1]); w.w = cvt_pk_bf16(v1[2], v1[3]); return w; }
__device__ __forceinline__ void unpack8(const u32x4 w, f32x4& v0, f32x4& v1) { v0 = (f32x4){bf_lo(w.x), bf_hi(w.x), bf_lo(w.y), bf_hi(w.y)}; v1 = (f32x4){bf_lo(w.z), bf_hi(w.z), bf_lo(w.w), bf_hi(w.w)}; }
__device__ __forceinline__ float sigmoidf_(float x) { return __builtin_amdgcn_rcpf(1.0f + __builtin_amdgcn_exp2f(-1.4426950408889634f * x)); }

constexpr int MTOK = 16384;
constexpr float QSCALE = 0.125f * 1.4426950408889634f;
constexpr float NEPS = 1e-6f;

struct EpiPlain {
    static constexpr bool PERM = true, AFTER_DRAIN = false;
    bf16_t* O; int ldc;
    __device__ __forceinline__ void operator()(const f32x4 (&acc)[2][2][4][2], const Unit& u, int wr, int wc, int fr, int fq) const {
        const int row0 = u.pm * BM + wr * 64 + fr, col0 = u.pn * BM + wc * 32 + 8 * fq;
#pragma unroll
        for (int ai = 0; ai < 2; ++ai)
#pragma unroll
            for (int m = 0; m < 4; ++m) { bf16_t* rowp = O + (size_t)(row0 + ai * HALF + m * 16) * ldc + col0;
#pragma unroll
                for (int bj = 0; bj < 2; ++bj) *(u32x4*)(rowp + bj * HALF) = pack8(acc[ai][bj][m][0], acc[ai][bj][m][1]); }
    }
};

struct EpiIn {
    static constexpr bool PERM = true, AFTER_DRAIN = false;
    bf16_t* P; const float* qg; const float* kg;
    __device__ __forceinline__ void operator()(const f32x4 (&acc)[2][2][4][2], const Unit& u, int wr, int wc, int fr, int fq) const {
        const int pn = u.pn; int mode, ldc, ct; bf16_t* base;
        if (pn < 12) { const int b = pn >> 1; base = P + (size_t)b * ((size_t)MTOK * 512); ldc = 512; ct = (pn & 1) * 256; mode = (b == 0) ? 1 : (b == 1) ? 2 : 0; }
        else { const int b = (pn - 12) >> 2; base = P + (size_t)6 * MTOK * 512 + (size_t)b * ((size_t)MTOK * 1024); ldc = 1024; ct = ((pn - 12) & 3) * 256; mode = 3; }
        const int row0 = u.pm * BM + wr * 64 + fr, dcol = ct + 64 * wc + 8 * fq;
        f32x4 gv[2][2];
        if (mode == 1 || mode == 2) { const float* g = (mode == 1) ? qg : kg; const float sc = (mode == 1) ? QSCALE : 1.0f;
#pragma unroll
            for (int bj = 0; bj < 2; ++bj)
#pragma unroll
                for (int n = 0; n < 2; ++n) gv[bj][n] = *(const f32x4*)(g + 32 * bj + 8 * fq + 4 * n) * sc; }
#pragma unroll
        for (int ai = 0; ai < 2; ++ai)
#pragma unroll
            for (int m = 0; m < 4; ++m) {
                f32x4 v[2][2];
#pragma unroll
                for (int bj = 0; bj < 2; ++bj)
#pragma unroll
                    for (int n = 0; n < 2; ++n) v[bj][n] = acc[ai][bj][m][n];
                if (mode == 1 || mode == 2) {
                    float ss = 0.f;
#pragma unroll
                    for (int bj = 0; bj < 2; ++bj)
#pragma unroll
                        for (int n = 0; n < 2; ++n) { const f32x4 x = v[bj][n]; ss += (x[0] * x[0] + x[1] * x[1]) + (x[2] * x[2] + x[3] * x[3]); }
                    ss += __shfl_xor(ss, 16); ss += __shfl_xor(ss, 32);
                    const float rs = __builtin_amdgcn_rsqf(ss * (1.0f / 64.0f) + NEPS);
#pragma unroll
                    for (int bj = 0; bj < 2; ++bj)
#pragma unroll
                        for (int n = 0; n < 2; ++n) v[bj][n] = v[bj][n] * rs * gv[bj][n];
                } else if (mode == 3) {
#pragma unroll
                    for (int bj = 0; bj < 2; ++bj)
#pragma unroll
                        for (int n = 0; n < 2; ++n) { f32x4 x = v[bj][n]; x[0] = sigmoidf_(x[0]); x[1] = sigmoidf_(x[1]); x[2] = sigmoidf_(x[2]); x[3] = sigmoidf_(x[3]); v[bj][n] = x; }
                }
                bf16_t* rowp = base + (size_t)(row0 + ai * HALF + m * 16) * ldc + dcol;
#pragma unroll
                for (int bj = 0; bj < 2; ++bj) *(u32x4*)(rowp + 32 * bj) = pack8(v[bj][0], v[bj][1]);
            }
    }
};

template <bool ADD> struct EpiGate {
    static constexpr bool PERM = true, AFTER_DRAIN = false;
    const bf16_t* G; bf16_t* Mg;
    __device__ __forceinline__ void operator()(const f32x4 (&acc)[2][2][4][2], const Unit& u, int wr, int wc, int fr, int fq) const {
        const int row0 = u.pm * BM + wr * 64 + fr, col0 = u.pn * BM + wc * 32 + 8 * fq;
#pragma unroll
        for (int ai = 0; ai < 2; ++ai)
#pragma unroll
            for (int m = 0; m < 4; ++m) { const size_t off = (size_t)(row0 + ai * HALF + m * 16) * 1024 + col0;
#pragma unroll
                for (int bj = 0; bj < 2; ++bj) { f32x4 g0, g1; unpack8(*(const u32x4*)(G + off + bj * HALF), g0, g1);
                    f32x4 r0 = g0 * acc[ai][bj][m][0], r1 = g1 * acc[ai][bj][m][1];
                    if (ADD) { f32x4 p0, p1; unpack8(*(const u32x4*)(Mg + off + bj * HALF), p0, p1); r0 += p0; r1 += p1; }
                    *(u32x4*)(Mg + off + bj * HALF) = pack8(r0, r1); } }
    }
};

struct EpiResid {
    static constexpr bool PERM = false, AFTER_DRAIN = false;
    const float* base; float* out;
    __device__ __forceinline__ void operator()(const f32x4 (&acc)[2][2][4][2], const Unit& u, int wr, int wc, int fr, int fq) const {
        const int row0 = u.pm * BM + wr * 64 + fr, col0 = u.pn * BM + wc * 32 + 4 * fq;
#pragma unroll
        for (int ai = 0; ai < 2; ++ai)
#pragma unroll
            for (int m = 0; m < 4; ++m) { const size_t off = (size_t)(row0 + ai * HALF + m * 16) * 1024 + col0;
#pragma unroll
                for (int bj = 0; bj < 2; ++bj)
#pragma unroll
                    for (int n = 0; n < 2; ++n) { const f32x4 b = *(const f32x4*)(base + off + bj * HALF + n * 16); *(f32x4*)(out + off + bj * HALF + n * 16) = b + acc[ai][bj][m][n]; }
                if (m & 1) asm volatile("" ::: "memory"); }
    }
};

struct EpiSwiglu {
    static constexpr bool PERM = true, AFTER_DRAIN = false;
    bf16_t* O;
    __device__ __forceinline__ void operator()(const f32x4 (&acc)[2][2][4][2], const Unit& u, int wr, int wc, int fr, int fq) const {
        const int row0 = u.pm * BM + wr * 64 + fr, col0 = u.pn * HALF + wc * 32 + 8 * fq;
#pragma unroll
        for (int ai = 0; ai < 2; ++ai)
#pragma unroll
            for (int m = 0; m < 4; ++m) { f32x4 r[2];
#pragma unroll
                for (int n = 0; n < 2; ++n) { const f32x4 g = acc[ai][0][m][n], v = acc[ai][1][m][n];
#pragma unroll
                    for (int e = 0; e < 4; ++e) r[n][e] = g[e] * sigmoidf_(g[e]) * v[e]; }
                *(u32x4*)(O + (size_t)(row0 + ai * HALF + m * 16) * 2816 + col0) = pack8(r[0], r[1]); }
    }
};

template <class Epi, class Sched, bool ALIGN_EPI = false, bool SP2 = false>
__device__ __forceinline__ void gemm_phase(PG8_LAS unsigned char* lds, const Gemm g, const Sched& S, const Epi& E) {
    int tid_ = threadIdx.x; asm volatile("" : "+v"(tid_));
    const int tid = tid_, wid = __builtin_amdgcn_readfirstlane(tid >> 6), lane = tid & 63, wr = wid >> 2, wc = wid & 3, fr = lane & 15, fq = lane >> 4;
    const int K = g.K, nt = K / BK;
    unsigned voffA[2], voffB[2];
#pragma unroll
    for (int i = 0; i < 2; ++i) { int R, C; stage_rc(tid * 16 + i * 8192, R, C); const int Rb = Epi::PERM ? ((R & ~31) + perm32(R & 31)) : R;
        voffA[i] = (unsigned)(R * K + C) * 2u; voffB[i] = (unsigned)(Rb * K + C) * 2u; }
    const size_t kstep = (size_t)(BK * 2);
    const size_t hstep = (size_t)HALF * K * 2;
    const size_t tstep = 2 * hstep;
    const unsigned ldsw = (unsigned)wid * 1024u;
    const int aoff = lds_byte(wr * 64 + fr, fq * 8), boff = lds_byte(wc * 32 + fr, fq * 8);
#define PG8_SA(b, h) (((b) * 2 + (h)) * HTB)
#define PG8_SB(b, h) ((4 + (b) * 2 + (h)) * HTB)
#define PG8_STAGE(bufoff, gbase, voff) do { _Pragma("unroll") for (int _i = 0; _i < 2; ++_i) \
        __builtin_amdgcn_global_load_lds((const unsigned*)((const char*)(gbase) + (voff)[_i]), (PG8_LAS unsigned*)(lds + (bufoff) + ldsw + _i * 8192), 16, 0, 0); } while (0)
#define PG8_LDA(dst, b, h) do { _Pragma("unroll") for (int m = 0; m < 4; ++m) _Pragma("unroll") for (int k = 0; k < 2; ++k) dst[m][k] = *(const PG8_LAS bf16x8*)(lds + PG8_SA(b, h) + aoff + m * 2048 + k * 1024); } while (0)
#define PG8_LDB(dst, b, h) do { _Pragma("unroll") for (int n = 0; n < 2; ++n) _Pragma("unroll") for (int k = 0; k < 2; ++k) dst[n][k] = *(const PG8_LAS bf16x8*)(lds + PG8_SB(b, h) + boff + n * 2048 + k * 1024); } while (0)
#define PG8_MMA(ai, bj, At, Bt) do { __builtin_amdgcn_s_setprio(1); _Pragma("unroll") for (int m = 0; m < 4; ++m) _Pragma("unroll") for (int n = 0; n < 2; ++n) _Pragma("unroll") for (int k = 0; k < 2; ++k) \
        acc[ai][bj][m][n] = __builtin_amdgcn_mfma_f32_16x16x32_bf16(Bt[n][k], At[m][k], acc[ai][bj][m][n], 0, 0, 0); __builtin_amdgcn_s_setprio(0); } while (0)
#define PG8_WAIT_V(n) asm volatile("s_waitcnt vmcnt(" #n ")" ::: "memory")
#define PG8_WAIT_L(n) asm volatile("s_waitcnt lgkmcnt(" #n ")" ::: "memory")
#define PG8_BAR __builtin_amdgcn_s_barrier()
#define PG8_SCHED __builtin_amdgcn_sched_barrier(0)
    Unit cur, nxt; int ui = 0;
    if (!S.next(0, cur)) return;
    f32x4 acc[2][2][4][2];
#pragma unroll
    for (int a = 0; a < 2; ++a)
#pragma unroll
        for (int b = 0; b < 2; ++b)
#pragma unroll
            for (int m = 0; m < 4; ++m)
#pragma unroll
                for (int n = 0; n < 2; ++n) acc[a][b][m][n] = (f32x4){0.f, 0.f, 0.f, 0.f};
    bf16x8 At[4][2], B0[2][2], B1[2][2];
    const char* cA = (const char*)g.A + (size_t)cur.pm * tstep; const char* cB = (const char*)g.Bt + (size_t)cur.pn * tstep;
    S.a_ready(cur);
    if constexpr (SP2) {
        PG8_STAGE(PG8_SB(0, 0), cB, voffB); PG8_STAGE(PG8_SB(0, 1), cB + hstep, voffB); PG8_STAGE(PG8_SA(0, 0), cA, voffA); PG8_STAGE(PG8_SA(0, 1), cA + hstep, voffA);
        if (wr == 1) PG8_BAR;
        PG8_WAIT_V(2); PG8_BAR;
        PG8_STAGE(PG8_SB(1, 0), cB + kstep, voffB); PG8_STAGE(PG8_SA(1, 0), cA + kstep, voffA); PG8_STAGE(PG8_SB(1, 1), cB + hstep + kstep, voffB);
        PG8_WAIT_V(6); PG8_BAR;
    } else {
        PG8_STAGE(PG8_SB(0, 0), cB, voffB); PG8_STAGE(PG8_SA(0, 0), cA, voffA); PG8_STAGE(PG8_SB(0, 1), cB + hstep, voffB); PG8_STAGE(PG8_SA(0, 1), cA + hstep, voffA);
        if (wr == 1) PG8_BAR;
        PG8_WAIT_V(4); PG8_BAR;
        PG8_STAGE(PG8_SB(1, 0), cB + kstep, voffB); PG8_STAGE(PG8_SA(1, 0), cA + kstep, voffA); PG8_STAGE(PG8_SB(1, 1), cB + hstep + kstep, voffB);
        PG8_WAIT_V(6); PG8_BAR;
    }
    for (;;) {
        const bool has_next = S.next(ui + 1, nxt);
        const char* nA = has_next ? (const char*)g.A + (size_t)nxt.pm * tstep : cA; const char* nB = has_next ? (const char*)g.Bt + (size_t)nxt.pn * tstep : cB;
        for (int t = 0; t < nt; t += 2) {
            const bool last = (t == nt - 2);
            const char* a1 = cA + (size_t)(t + 1) * kstep;
            const char* a2 = last ? nA : cA + (size_t)(t + 2) * kstep; const char* b2 = last ? nB : cB + (size_t)(t + 2) * kstep;
            const char* a3 = a2 + kstep; const char* b3 = b2 + kstep;
            if (last && has_next) S.a_ready(nxt);
            if constexpr (SP2) {
            PG8_LDB(B0, 0, 0); PG8_LDB(B1, 0, 1); PG8_SCHED; PG8_LDA(At, 0, 0); PG8_STAGE(PG8_SA(1, 1), a1 + hstep, voffA);
            PG8_WAIT_V(8); PG8_WAIT_L(0); PG8_BAR; PG8_MMA(0, 0, At, B0); PG8_MMA(0, 1, At, B1); PG8_BAR; PG8_SCHED;
            PG8_LDA(At, 0, 1); PG8_STAGE(PG8_SB(0, 0), b2, voffB); PG8_STAGE(PG8_SB(0, 1), b2 + hstep, voffB); PG8_STAGE(PG8_SA(0, 0), a2, voffA);
            PG8_WAIT_V(8); PG8_WAIT_L(0); PG8_BAR; PG8_MMA(1, 0, At, B0); PG8_MMA(1, 1, At, B1); PG8_BAR; PG8_SCHED;
            PG8_LDB(B0, 1, 0); PG8_LDB(B1, 1, 1); PG8_SCHED; PG8_LDA(At, 1, 0); PG8_STAGE(PG8_SA(0, 1), a2 + hstep, voffA);
            PG8_WAIT_V(8); PG8_WAIT_L(0); PG8_BAR; PG8_MMA(0, 0, At, B0); PG8_MMA(0, 1, At, B1); PG8_BAR; PG8_SCHED;
            PG8_LDA(At, 1, 1); PG8_STAGE(PG8_SB(1, 0), b3, voffB); PG8_STAGE(PG8_SB(1, 1), b3 + hstep, voffB); PG8_STAGE(PG8_SA(1, 0), a3, voffA);
            PG8_WAIT_V(8); PG8_WAIT_L(0); PG8_BAR; PG8_MMA(1, 0, At, B0); PG8_MMA(1, 1, At, B1); PG8_BAR; PG8_SCHED;
            } else {
            PG8_LDB(B0, 0, 0); PG8_SCHED; PG8_LDA(At, 0, 0); PG8_STAGE(PG8_SA(1, 1), a1 + hstep, voffA);
            PG8_WAIT_L(8); PG8_BAR; PG8_WAIT_L(0); PG8_MMA(0, 0, At, B0); PG8_BAR; PG8_SCHED;
            PG8_LDB(B1, 0, 1); PG8_STAGE(PG8_SB(0, 0), b2, voffB);
            PG8_BAR; PG8_WAIT_L(0); PG8_MMA(0, 1, At, B1); PG8_BAR;
            PG8_LDA(At, 0, 1); PG8_STAGE(PG8_SA(0, 0), a2, voffA);
            PG8_BAR; PG8_WAIT_L(0); PG8_MMA(1, 0, At, B0); PG8_BAR; PG8_SCHED;
            PG8_STAGE(PG8_SB(0, 1), b2 + hstep, voffB);
            PG8_WAIT_V(6); PG8_BAR; PG8_MMA(1, 1, At, B1); PG8_BAR;
            PG8_LDB(B0, 1, 0); PG8_SCHED; PG8_LDA(At, 1, 0); PG8_STAGE(PG8_SA(0, 1), a2 + hstep, voffA);
            PG8_WAIT_L(8); PG8_BAR; PG8_WAIT_L(0); PG8_MMA(0, 0, At, B0); PG8_BAR; PG8_SCHED;
            PG8_LDB(B1, 1, 1); PG8_STAGE(PG8_SB(1, 0), b3, voffB);
            PG8_BAR; PG8_WAIT_L(0); PG8_MMA(0, 1, At, B1); PG8_BAR;
            PG8_LDA(At, 1, 1); PG8_STAGE(PG8_SA(1, 0), a3, voffA);
            PG8_BAR; PG8_WAIT_L(0); PG8_MMA(1, 0, At, B0); PG8_BAR; PG8_SCHED;
            PG8_STAGE(PG8_SB(1, 1), b3 + hstep, voffB);
            PG8_WAIT_V(6); PG8_BAR; PG8_MMA(1, 1, At, B1); PG8_BAR;
            }
        }
        if constexpr (ALIGN_EPI) { if (wr == 0) PG8_BAR; }
        if constexpr (!Epi::AFTER_DRAIN) { E(acc, cur, wr, wc, fr, fq); S.done(cur); }
        if (!has_next) break;
#pragma unroll
        for (int a = 0; a < 2; ++a)
#pragma unroll
            for (int b = 0; b < 2; ++b)
#pragma unroll
                for (int m = 0; m < 4; ++m)
#pragma unroll
                    for (int n = 0; n < 2; ++n) acc[a][b][m][n] = (f32x4){0.f, 0.f, 0.f, 0.f};
        cur = nxt; cA = nA; cB = nB; ++ui;
        if constexpr (ALIGN_EPI) { if (wr == 1) PG8_BAR; }
    }
    PG8_WAIT_V(0);
    if constexpr (!ALIGN_EPI) { if (wr == 0) PG8_BAR; }
    PG8_BAR;
    if constexpr (Epi::AFTER_DRAIN) { E.fused(acc, cur, wr, wc, fr, fq, lds, wid, lane); S.done(cur); }
#undef PG8_SA
#undef PG8_SB
#undef PG8_STAGE
#undef PG8_LDA
#undef PG8_LDB
#undef PG8_MMA
#undef PG8_WAIT_V
#undef PG8_WAIT_L
#undef PG8_BAR
#undef PG8_SCHED
}
}

#define LAS __attribute__((address_space(3)))
using pg8::bf16_t; using pg8::bf16x8; using pg8::f32x4; using pg8::u32x4;
typedef float f32x16 __attribute__((ext_vector_type(16)));
typedef short v4i16_t __attribute__((ext_vector_type(4)));
typedef unsigned u32x2 __attribute__((ext_vector_type(2)));

constexpr int M = 16384, T = 2048, NBATCH = 8, D = 1024, DEPTH = 4, INW = 5128, NIN = 5120, DFF = 2816, NGU = 5632, MEMT = 256, MROWS = NBATCH * MEMT;
constexpr float LOG2E = 1.4426950408889634f;
constexpr float MSCALE = 0.08838834764831845f * 1.4426950408889634f;
constexpr size_t MiB = 1u << 20;
constexpr size_t WS_LOGF = 1 * MiB;
constexpr size_t WS_CUM = WS_LOGF + 512 * 1024;
constexpr size_t WS_W = 2 * MiB;
constexpr size_t W_IN = 0, W_UA = 5242880, W_UB = 5767168, W_O = 6291456, W_CQ = 7340032, W_CO = 7864320, W_GU = 8388608, W_DN = 14155776, W_LAYER = 17039360;
constexpr size_t WS_U = WS_W + 130 * MiB;
constexpr size_t WS_KVM = WS_U + 32 * MiB;
constexpr size_t WS_P = WS_KVM + 16 * MiB;
constexpr size_t WS_END = WS_P + 160 * MiB;
static_assert(W_LAYER * 2 * 4 == 130 * MiB, "weights");
constexpr size_t P_Q = 0, P_K = 16 * MiB, P_V = 32 * MiB, P_Z = 48 * MiB, P_GB = 64 * MiB, P_GC = 80 * MiB, P_SGA = 96 * MiB, P_SGB = 128 * MiB;
constexpr size_t P_MRG = P_K;
constexpr size_t P_QM = P_Z;
constexpr size_t P_ACT = 0;
constexpr size_t P_MEMHAT = 0;
constexpr size_t P_WCKV = 16 * MiB;
constexpr int LDS_BYTES = 147456;

__device__ __forceinline__ float wave_sum(float v) {
#pragma unroll
    for (int o = 1; o < 64; o <<= 1) v += __shfl_xor(v, o);
    return v;
}
__device__ __forceinline__ unsigned pk2(float lo, float hi) { return pg8::cvt_pk_bf16(lo, hi); }

__device__ __forceinline__ int srcmap(int map, int n) {
    if (map == 1) { const int tile = n >> 8, c = n & 255; const int o = tile * 256 + 64 * ((c >> 5) & 3) + 32 * (c >> 7) + (c & 31); return o >= 1536 ? o + 8 : o; }
    if (map == 2) { const int tile = n >> 8, c = n & 255; return c < 128 ? tile * 128 + c : DFF + tile * 128 + (c - 128); }
    return n;
}
__device__ __forceinline__ void cvt_item(const float* W, int K, int Nsrc, int nblk, bf16_t* dst, int map, const float* gain, LAS float* scr, int item, int lane) {
    const int kb = item / nblk, nb = item % nblk, k0 = 64 * kb, n0 = 64 * nb;
    const int sc = srcmap(map, n0 + lane);
    const float* src = W + (size_t)k0 * Nsrc + sc;
#pragma unroll 8
    for (int i = 0; i < 64; ++i) { float v = src[(size_t)i * Nsrc]; if (gain) v *= gain[k0 + i]; scr[i * 65 + lane] = v; }
    asm volatile("s_waitcnt lgkmcnt(0)" ::: "memory");
    const int c = lane & 7;
#pragma unroll
    for (int j = 0; j < 8; ++j) { const int n = (lane >> 3) + 8 * j; const LAS float* s = scr + (8 * c) * 65 + n;
        u32x4 o; o.x = pk2(s[0], s[65]); o.y = pk2(s[2 * 65], s[3 * 65]); o.z = pk2(s[4 * 65], s[5 * 65]); o.w = pk2(s[6 * 65], s[7 * 65]);
        *(u32x4*)(dst + (size_t)(n0 + n) * K + k0 + 8 * c) = o; }
    asm volatile("s_waitcnt lgkmcnt(0)" ::: "memory");
}
struct CvtJob { const float* W; int K, Nsrc, Ndst, map; bf16_t* dst; const float* gain; };

template <bool FLOGIT>
__device__ __forceinline__ void norm_rows(const float* src, const float* gain, bf16_t* dst, int nrows, int gw, int NGW, int lane, LAS const float* wf, const float* bf, float* logf) {
    f32x4 gv[4];
#pragma unroll
    for (int j = 0; j < 4; ++j) gv[j] = gain ? ((const f32x4*)gain)[lane + 64 * j] : (f32x4){1.f, 1.f, 1.f, 1.f};
    for (int row = gw; row < nrows; row += NGW) {
        const f32x4* xr = (const f32x4*)(src + (size_t)row * D) + lane;
        f32x4 v[4]; float ss = 0.f;
#pragma unroll
        for (int j = 0; j < 4; ++j) { v[j] = xr[64 * j]; ss += (v[j][0] * v[j][0] + v[j][1] * v[j][1]) + (v[j][2] * v[j][2] + v[j][3] * v[j][3]); }
        const float rstd = 1.0f / sqrtf(wave_sum(ss) * (1.0f / D) + 1e-6f);
        u32x2* o8 = (u32x2*)(dst + (size_t)row * D) + lane;
#pragma unroll
        for (int j = 0; j < 4; ++j) { v[j] = v[j] * rstd * gv[j]; u32x2 w; w.x = pk2(v[j][0], v[j][1]); w.y = pk2(v[j][2], v[j][3]); o8[64 * j] = w; }
        if (FLOGIT) {
            float a[8];
#pragma unroll
            for (int i = 0; i < 8; ++i) a[i] = 0.f;
#pragma unroll
            for (int j = 0; j < 4; ++j)
#pragma unroll
                for (int e = 0; e < 4; ++e) { const LAS f32x4* wp = (const LAS f32x4*)(wf + ((j * 4 + e) * 64 + lane) * 8); const f32x4 w0 = wp[0], w1 = wp[1]; const float x = v[j][e];
                    a[0] += x * w0[0]; a[1] += x * w0[1]; a[2] += x * w0[2]; a[3] += x * w0[3]; a[4] += x * w1[0]; a[5] += x * w1[1]; a[6] += x * w1[2]; a[7] += x * w1[3]; }
            float mine = 0.f;
#pragma unroll
            for (int i = 0; i < 8; ++i) { const float s = wave_sum(a[i]); if (lane == i) mine = s; }
            if (lane < 8) { const float x = mine + bf[lane]; logf[(size_t)row * 8 + lane] = fminf(x, 0.f) - log1pf(expf(-fabsf(x))); }
        }
    }
}

__device__ __forceinline__ int crow(int r, int hi) { return (r & 3) + 8 * (r >> 2) + 4 * hi; }
template <int HD, bool FOX>
__device__ __forceinline__ void attn_unit(LAS unsigned char* lds, const bf16_t* Qb, int ldq, const bf16_t* Kb, const bf16_t* Vb, int ldk, bf16_t* Ob, int nkt, int tband, const float* cp, int q0, const float* qgain, const float* kgain) {
    constexpr int KS = HD / 16, DB = HD / 32, NCH = HD / 64, KP = HD * 2 + 16, KBUF = 64 * KP, VBUF = DB * 4096;
    constexpr int OFF_K = 0, OFF_V = 2 * KBUF, OFF_CK = OFF_V + 2 * VBUF, OFF_WS = OFF_CK + 512;
    int tid_ = threadIdx.x; asm volatile("" : "+v"(tid_));
    const int tid = tid_, lane = tid & 63, wid = __builtin_amdgcn_readfirstlane(tid >> 6), r32 = lane & 31, hi = lane >> 5;
    LAS float* wsf = (LAS float*)(lds + OFF_WS) + wid * 64;
    bf16x8 qr[KS];
    { const bf16_t* qrow = Qb + (size_t)(wid * 32 + r32) * ldq + hi * 8;
#pragma unroll
      for (int ks = 0; ks < KS; ++ks) qr[ks] = *(const bf16x8*)(qrow + ks * 16);
      if (!FOX) {
          float ss = 0.f;
#pragma unroll
          for (int ks = 0; ks < KS; ++ks)
#pragma unroll
              for (int e = 0; e < 8; ++e) { const float x = __uint_as_float(((unsigned)(unsigned short)qr[ks][e]) << 16); ss += x * x; }
          ss += __shfl_xor(ss, 32);
          const float rs = MSCALE / sqrtf(ss * (1.0f / HD) + 1e-6f);
#pragma unroll
          for (int ks = 0; ks < KS; ++ks) { const f32x4 g0 = *(const f32x4*)(qgain + ks * 16 + hi * 8), g1 = *(const f32x4*)(qgain + ks * 16 + hi * 8 + 4); u32x4 w;
              float x[8];
#pragma unroll
              for (int e = 0; e < 8; ++e) x[e] = __uint_as_float(((unsigned)(unsigned short)qr[ks][e]) << 16) * rs * (e < 4 ? g0[e & 3] : g1[e & 3]);
              w.x = pk2(x[0], x[1]); w.y = pk2(x[2], x[3]); w.z = pk2(x[4], x[5]); w.w = pk2(x[6], x[7]); qr[ks] = __builtin_bit_cast(bf16x8, w); }
      } }
    const float cq = FOX ? cp[q0 + wid * 32 + r32] : 0.f;
    const int skey = tid >> 3, sch = tid & 7;
    u32x4 kreg[NCH], vreg[NCH]; float ckreg = 0.f;
    f32x4 kg0[NCH], kg1[NCH];
    if (!FOX) {
#pragma unroll
        for (int i = 0; i < NCH; ++i) { kg0[i] = *(const f32x4*)(kgain + (sch + 8 * i) * 8); kg1[i] = *(const f32x4*)(kgain + (sch + 8 * i) * 8 + 4); }
    }
#define ATT_LOAD(t) do { _Pragma("unroll") for (int i_ = 0; i_ < NCH; ++i_) { const size_t go_ = (size_t)((t) * 64 + skey) * ldk + (sch + 8 * i_) * 8; kreg[i_] = *(const u32x4*)(Kb + go_); vreg[i_] = *(const u32x4*)(Vb + go_); } \
        if (FOX && tid < 64) ckreg = cp[(t) * 64 + tid]; } while (0)
#define ATT_STORE(buf) do { \
        if (!FOX) { float ss_ = 0.f; f32x4 a_[NCH][2]; _Pragma("unroll") for (int i_ = 0; i_ < NCH; ++i_) { pg8::unpack8(kreg[i_], a_[i_][0], a_[i_][1]); \
              _Pragma("unroll") for (int h_ = 0; h_ < 2; ++h_) ss_ += (a_[i_][h_][0] * a_[i_][h_][0] + a_[i_][h_][1] * a_[i_][h_][1]) + (a_[i_][h_][2] * a_[i_][h_][2] + a_[i_][h_][3] * a_[i_][h_][3]); } \
            ss_ += __shfl_xor(ss_, 1); ss_ += __shfl_xor(ss_, 2); ss_ += __shfl_xor(ss_, 4); const float rs_ = 1.0f / sqrtf(ss_ * (1.0f / HD) + 1e-6f); \
            _Pragma("unroll") for (int i_ = 0; i_ < NCH; ++i_) kreg[i_] = pg8::pack8(a_[i_][0] * rs_ * kg0[i_], a_[i_][1] * rs_ * kg1[i_]); } \
        _Pragma("unroll") for (int i_ = 0; i_ < NCH; ++i_) { const int c_ = sch + 8 * i_; \
            *(LAS u32x4*)(lds + OFF_K + (buf) * KBUF + skey * KP + c_ * 16) = kreg[i_]; \
            *(LAS u32x4*)(lds + OFF_V + (buf) * VBUF + (c_ >> 2) * 4096 + (skey >> 3) * 512 + (skey & 7) * 64 + (c_ & 3) * 16) = vreg[i_]; } \
        if (FOX && tid < 64) *(LAS float*)(lds + OFF_CK + (buf) * 256 + tid * 4) = ckreg; } while (0)
    float mrun = -INFINITY, lrun = 0.f;
    f32x16 o[DB];
#pragma unroll
    for (int d = 0; d < DB; ++d)
#pragma unroll
        for (int r = 0; r < 16; ++r) o[d][r] = 0.f;
    ATT_LOAD(nkt - 1); ATT_STORE(0);
    __syncthreads();
    const int thi = tband + (wid >> 1);
    const int vlane = ((lane >> 4) & 1) * 32 + (lane & 3) * 8 + (4 * hi + ((lane & 15) >> 2)) * 64;
    for (int it = 0; it < nkt; ++it) {
        const int t = nkt - 1 - it, cur = it & 1;
        if (it + 1 < nkt) ATT_LOAD(t - 1);
        if (!FOX || t <= thi) {
            f32x16 p0, p1;
#pragma unroll
            for (int r = 0; r < 16; ++r) { p0[r] = cq; p1[r] = cq; }
            const LAS unsigned char* kb = lds + OFF_K + cur * KBUF + r32 * KP + hi * 16;
#pragma unroll
            for (int ks = 0; ks < KS; ++ks) { const bf16x8 b0 = *(const LAS bf16x8*)(kb + ks * 32), b1 = *(const LAS bf16x8*)(kb + 32 * KP + ks * 32);
                p0 = __builtin_amdgcn_mfma_f32_32x32x16_bf16(b0, qr[ks], p0, 0, 0, 0); p1 = __builtin_amdgcn_mfma_f32_32x32x16_bf16(b1, qr[ks], p1, 0, 0, 0); }
            if (FOX) {
                const LAS float* ckp = (const LAS float*)(lds + OFF_CK + cur * 256) + 4 * hi;
#pragma unroll
                for (int g = 0; g < 4; ++g) { const f32x4 a = *(const LAS f32x4*)(ckp + 8 * g), b = *(const LAS f32x4*)(ckp + 32 + 8 * g);
#pragma unroll
                    for (int e = 0; e < 4; ++e) { p0[4 * g + e] -= a[e]; p1[4 * g + e] -= b[e]; } }
                if (t == thi) { const int qrel = 32 * (wid & 1) + r32;
#pragma unroll
                    for (int r = 0; r < 16; ++r) { const int kv = crow(r, hi); if (kv > qrel) p0[r] = -INFINITY; if (kv + 32 > qrel) p1[r] = -INFINITY; } }
            }
            float rm = fmaxf(p0[0], p1[0]);
#pragma unroll
            for (int r = 1; r < 16; ++r) rm = fmaxf(rm, fmaxf(p0[r], p1[r]));
            rm = fmaxf(rm, __shfl_xor(rm, 32));
            const float mn = fmaxf(mrun, rm);
            if (__any(mn > mrun)) {
                const float al = __builtin_amdgcn_exp2f(mrun - mn); lrun *= al; mrun = mn;
                if (hi == 0) wsf[r32] = al;
                asm volatile("s_waitcnt lgkmcnt(0)" ::: "memory");
#pragma unroll
                for (int g = 0; g < 4; ++g) { const f32x4 a = *(const LAS f32x4*)(wsf + 8 * g + 4 * hi);
#pragma unroll
                    for (int d = 0; d < DB; ++d)
#pragma unroll
                        for (int e = 0; e < 4; ++e) o[d][4 * g + e] *= a[e]; }
            }
            float sacc = 0.f;
#pragma unroll
            for (int r = 0; r < 16; ++r) { p0[r] = __builtin_amdgcn_exp2f(p0[r] - mrun); p1[r] = __builtin_amdgcn_exp2f(p1[r] - mrun); sacc += p0[r] + p1[r]; }
            lrun += sacc;
            bf16x8 pw[4];
#pragma unroll
            for (int j = 0; j < 2; ++j) { u32x4 w0, w1;
                w0.x = pk2(p0[8 * j + 0], p0[8 * j + 1]); w0.y = pk2(p0[8 * j + 2], p0[8 * j + 3]); w0.z = pk2(p0[8 * j + 4], p0[8 * j + 5]); w0.w = pk2(p0[8 * j + 6], p0[8 * j + 7]);
                w1.x = pk2(p1[8 * j + 0], p1[8 * j + 1]); w1.y = pk2(p1[8 * j + 2], p1[8 * j + 3]); w1.z = pk2(p1[8 * j + 4], p1[8 * j + 5]); w1.w = pk2(p1[8 * j + 6], p1[8 * j + 7]);
                pw[j] = __builtin_bit_cast(bf16x8, w0); pw[2 + j] = __builtin_bit_cast(bf16x8, w1); }
            const LAS unsigned char* vb = lds + OFF_V + cur * VBUF + vlane;
#pragma unroll
            for (int d = 0; d < DB; ++d)
#pragma unroll
                for (int j = 0; j < 4; ++j) {
                    const v4i16_t lo = __builtin_amdgcn_ds_read_tr16_b64_v4i16((LAS v4i16_t*)(vb + d * 4096 + j * 1024));
                    const v4i16_t hh = __builtin_amdgcn_ds_read_tr16_b64_v4i16((LAS v4i16_t*)(vb + d * 4096 + j * 1024 + 512));
                    const bf16x8 vf = (bf16x8){lo[0], lo[1], lo[2], lo[3], hh[0], hh[1], hh[2], hh[3]};
                    o[d] = __builtin_amdgcn_mfma_f32_32x32x16_bf16(pw[j], vf, o[d], 0, 0, 0);
                }
        }
        if (it + 1 < nkt) ATT_STORE(cur ^ 1);
        __syncthreads();
    }
#undef ATT_LOAD
#undef ATT_STORE
    lrun += __shfl_xor(lrun, 32);
    if (hi == 0) wsf[32 + r32] = lrun;
    asm volatile("s_waitcnt lgkmcnt(0)" ::: "memory");
    bf16_t* orow = Ob + (size_t)(wid * 32) * ldq + r32;
#pragma unroll
    for (int g = 0; g < 4; ++g) { const f32x4 lv = *(const LAS f32x4*)(wsf + 32 + 8 * g + 4 * hi);
#pragma unroll
        for (int e = 0; e < 4; ++e) { const float il = 1.0f / lv[e]; const int rr = crow(4 * g + e, hi);
#pragma unroll
            for (int d = 0; d < DB; ++d) orow[(size_t)rr * ldq + d * 32] = (bf16_t)(pk2(o[d][4 * g + e] * il, 0.f) & 0xffffu); } }
}

#ifndef PH_MASK
#define PH_MASK 0xffff
#endif
#define EN(k) (((PH_MASK) >> (k)) & 1)
struct Args { const float* in[21]; float* out; unsigned char* ws; int ph_lo, ph_hi; };
constexpr int N_PHASES = 2 + 12 * DEPTH;

__global__ void __launch_bounds__(512, 2) fwd_kernel(Args args) {
    extern __shared__ __attribute__((aligned(16))) unsigned char lds_raw[];
    LAS unsigned char* lds = (LAS unsigned char*)lds_raw;
    const int wave = __builtin_amdgcn_readfirstlane(threadIdx.x >> 6);
    const int G = gridDim.x, bx = blockIdx.x;
    const int vcu = (G % 8 == 0) ? (bx % 8) * (G / 8) + bx / 8 : bx;
    const int gw = vcu * 8 + wave, NGW = G * 8;
    unsigned char* ws = args.ws;
    const float* x_in = args.in[0]; const float* mem = args.in[1];
    float* hbuf = args.out;
    bf16_t* Wb = (bf16_t*)(ws + WS_W);
    bf16_t* U = (bf16_t*)(ws + WS_U);
    bf16_t* KVM = (bf16_t*)(ws + WS_KVM);
    unsigned char* Pr = ws + WS_P;
    float* logf = (float*)(ws + WS_LOGF);
    float* cum = (float*)(ws + WS_CUM);
    cg::grid_group grid = cg::this_grid();

    for (int ph = args.ph_lo; ph < args.ph_hi; ++ph) {
        int tid_ = threadIdx.x; asm volatile("" : "+v"(tid_));
        const int tid = tid_, lane = tid & 63;
        if (ph == 0) { if (EN(0)) {
            LAS float* scr = (LAS float*)lds + wave * (64 * 65);
            int pre = 0;
            for (int l = 0; l < DEPTH; ++l) {
                bf16_t* wl = Wb + (size_t)l * W_LAYER;
                for (int j = 0; j < 9; ++j) {
                    CvtJob jb;
                    switch (j) {
                    case 0: jb = CvtJob{args.in[3] + (size_t)l * D * INW, D, INW, NIN, 1, wl + W_IN, nullptr}; break;
                    case 1: jb = CvtJob{args.in[8] + (size_t)l * 512 * D, 512, D, D, 0, wl + W_UA, nullptr}; break;
                    case 2: jb = CvtJob{args.in[9] + (size_t)l * 512 * D, 512, D, D, 0, wl + W_UB, nullptr}; break;
                    case 3: jb = CvtJob{args.in[10] + (size_t)l * D * D, D, D, D, 0, wl + W_O, nullptr}; break;
                    case 4: jb = CvtJob{args.in[13] + (size_t)l * D * 512, D, 512, 512, 0, wl + W_CQ, nullptr}; break;
                    case 5: jb = CvtJob{args.in[14] + (size_t)l * D * 1024, D, 1024, 1024, 0, (bf16_t*)(Pr + P_WCKV) + (size_t)l * 1024 * D, args.in[12] + (size_t)l * D}; break;
                    case 6: jb = CvtJob{args.in[17] + (size_t)l * 512 * D, 512, D, D, 0, wl + W_CO, nullptr}; break;
                    case 7: jb = CvtJob{args.in[19] + (size_t)l * D * NGU, D, NGU, NGU, 2, wl + W_GU, nullptr}; break;
                    default: jb = CvtJob{args.in[20] + (size_t)l * DFF * D, DFF, D, D, 0, wl + W_DN, nullptr}; break;
                    }
                    const int nblk = jb.Ndst / 64, nitems = (jb.K / 64) * nblk;
                    int start = (gw - pre % NGW + NGW) % NGW;
                    for (int it = start; it < nitems; it += NGW) cvt_item(jb.W, jb.K, jb.Nsrc, nblk, jb.dst, jb.map, jb.gain, scr, it, lane);
                    pre += nitems;
                }
            }
            norm_rows<false>(mem, nullptr, (bf16_t*)(Pr + P_MEMHAT), MROWS, gw, NGW, lane, nullptr, nullptr, nullptr); }
        } else if (ph == 1) { if (EN(1)) {
            pg8::Gemm g{(const bf16_t*)(Pr + P_MEMHAT), (const bf16_t*)(Pr + P_WCKV), MROWS, 4096, D}; pg8::StaticOrder S; S.init(MROWS, 4096, G, bx);
            pg8::EpiPlain E{KVM, 4096};
            pg8::gemm_phase<pg8::EpiPlain, pg8::StaticOrder, true, true>(lds, g, S, E); }
        } else {
            const int l = (ph - 2) / 12, sp = (ph - 2) % 12;
            const bf16_t* wl = Wb + (size_t)l * W_LAYER;
            const float* hin = (l == 0 && sp <= 4) ? x_in : hbuf;
            if (sp == 0 || sp == 5 || sp == 9) { if (EN(2)) {
                if (sp == 0) {
                    const float* wf_src = args.in[3] + (size_t)l * D * INW + 1536;
                    LAS float* wf = (LAS float*)lds;
                    for (int i = tid; i < 1024 * 8; i += 512) { const int k = i >> 3, c = i & 7; const int j = k >> 8, ln = (k & 255) >> 2, e = k & 3; wf[((j * 4 + e) * 64 + ln) * 8 + c] = wf_src[(size_t)k * INW + c]; }
                    __syncthreads();
                    norm_rows<true>(hin, args.in[2] + (size_t)l * D, U, M, gw, NGW, lane, wf, args.in[4] + l * 8, logf);
                    __syncthreads();
                } else {
                    norm_rows<false>(hin, (sp == 5 ? args.in[11] : args.in[18]) + (size_t)l * D, U, M, gw, NGW, lane, nullptr, nullptr, nullptr);
                } }
            } else if (sp == 1) { if (EN(3)) {
                if (bx < NBATCH) {
                    const float* src = logf + ((size_t)bx * T + 32 * lane) * 8 + wave;
                    float xs[32]; float run = 0.f;
#pragma unroll
                    for (int i = 0; i < 32; ++i) { run += src[i * 8]; xs[i] = run; }
                    float inc = run;
#pragma unroll
                    for (int o = 1; o < 64; o <<= 1) { const float y = __shfl_up(inc, o); if (lane >= o) inc += y; }
                    const float excl = inc - run;
                    float* dstc = cum + ((size_t)(bx * 8 + wave)) * T + 32 * lane;
#pragma unroll
                    for (int i = 0; i < 32; ++i) dstc[i] = (excl + xs[i]) * LOG2E;
                }
                pg8::Gemm g{U, wl + W_IN, M, NIN, D}; pg8::StaticOrder S; S.init(M, NIN, G, bx);
                pg8::EpiIn E{(bf16_t*)Pr, args.in[5] + l * 64, args.in[6] + l * 64};
                pg8::gemm_phase<pg8::EpiIn, pg8::StaticOrder, true, true>(lds, g, S, E); }
            } else if (sp == 2) { if (EN(4)) {
                bf16_t* Qb = (bf16_t*)(Pr + P_Q); const bf16_t* Kb = (const bf16_t*)(Pr + P_K); const bf16_t* Vb = (const bf16_t*)(Pr + P_V);
                for (int v = vcu; v < 256; v += G) {
                    const int bh = v >> 2, s = v & 3, b = bh >> 3, h = bh & 7;
                    for (int half = 0; half < 2; ++half) {
                        const int qb = half ? 7 - s : s;
                        const size_t rb = (size_t)b * T;
                        attn_unit<64, true>(lds, Qb + (rb + qb * 256) * 512 + h * 64, 512, Kb + rb * 512 + h * 64, Vb + rb * 512 + h * 64, 512, Qb + (rb + qb * 256) * 512 + h * 64,
                                            4 * (qb + 1), 4 * qb, cum + (size_t)bh * T, qb * 256, nullptr, nullptr);
                    }
                }
                {
                    const bf16_t* Zb = (const bf16_t*)(Pr + P_Z); bf16_t* GBb = (bf16_t*)(Pr + P_GB); const bf16_t* GCb = (const bf16_t*)(Pr + P_GC);
                    const float* cw = args.in[7] + (size_t)l * 3 * 512 + lane * 8;
                    f32x4 w0a = *(const f32x4*)(cw), w0b = *(const f32x4*)(cw + 4), w1a = *(const f32x4*)(cw + 512), w1b = *(const f32x4*)(cw + 516), w2a = *(const f32x4*)(cw + 1024), w2b = *(const f32x4*)(cw + 1028);
                    for (int item = gw; item < M / 8; item += NGW) {
                        const int r0 = item * 8; const size_t eo = (size_t)r0 * 512 + lane * 8;
                        f32x4 xm2a = {0.f, 0.f, 0.f, 0.f}, xm2b = xm2a, xm1a = xm2a, xm1b = xm2a;
                        if ((r0 & (T - 1)) != 0) { f32x4 za, zb, ca, cb;
                            pg8::unpack8(*(const u32x4*)(Zb + eo - 1024), za, zb); pg8::unpack8(*(const u32x4*)(GCb + eo - 1024), ca, cb); xm2a = za * ca; xm2b = zb * cb;
                            pg8::unpack8(*(const u32x4*)(Zb + eo - 512), za, zb); pg8::unpack8(*(const u32x4*)(GCb + eo - 512), ca, cb); xm1a = za * ca; xm1b = zb * cb; }
#pragma unroll
                        for (int i = 0; i < 8; ++i) { f32x4 za, zb, ca, cb, ga, gb2;
                            pg8::unpack8(*(const u32x4*)(Zb + eo + i * 512), za, zb); pg8::unpack8(*(const u32x4*)(GCb + eo + i * 512), ca, cb); pg8::unpack8(*(const u32x4*)(GBb + eo + i * 512), ga, gb2);
                            const f32x4 xa = za * ca, xb = zb * cb;
                            const f32x4 ya = ga * (w0a * xm2a + w1a * xm1a + w2a * xa), yb = gb2 * (w0b * xm2b + w1b * xm1b + w2b * xb);
                            *(u32x4*)(GBb + eo + i * 512) = pg8::pack8(ya, yb);
                            xm2a = xm1a; xm2b = xm1b; xm1a = xa; xm1b = xb; }
                    }
                } }
            } else if (sp == 3) { if (EN(5)) {
                pg8::StaticOrder S; S.init(M, D, G, bx);
                { pg8::Gemm g{(const bf16_t*)(Pr + P_Q), wl + W_UA, M, D, 512}; pg8::EpiGate<false> E{(const bf16_t*)(Pr + P_SGA), (bf16_t*)(Pr + P_MRG)};
                  pg8::gemm_phase<pg8::EpiGate<false>, pg8::StaticOrder, true, true>(lds, g, S, E); }
                { pg8::Gemm g{(const bf16_t*)(Pr + P_GB), wl + W_UB, M, D, 512}; pg8::EpiGate<true> E{(const bf16_t*)(Pr + P_SGB), (bf16_t*)(Pr + P_MRG)};
                  pg8::gemm_phase<pg8::EpiGate<true>, pg8::StaticOrder, true, true>(lds, g, S, E); } }
            } else if (sp == 4) { if (EN(6)) {
                pg8::Gemm g{(const bf16_t*)(Pr + P_MRG), wl + W_O, M, D, D}; pg8::StaticOrder S; S.init(M, D, G, bx);
                pg8::EpiResid E{hin, hbuf};
                pg8::gemm_phase<pg8::EpiResid, pg8::StaticOrder, true, true>(lds, g, S, E); }
            } else if (sp == 6) { if (EN(7)) {
                pg8::Gemm g{U, wl + W_CQ, M, 512, D}; pg8::StaticOrder S; S.init(M, 512, G, bx);
                pg8::EpiPlain E{(bf16_t*)(Pr + P_QM), 512};
                pg8::gemm_phase<pg8::EpiPlain, pg8::StaticOrder, true, true>(lds, g, S, E); }
            } else if (sp == 7) { if (EN(8)) {
                bf16_t* Qm = (bf16_t*)(Pr + P_QM);
                for (int v = vcu; v < 256; v += G) {
                    const int b = v >> 5, h = (v >> 3) & 3, qb = v & 7;
                    const bf16_t* Kb = KVM + (size_t)b * MEMT * 4096 + l * 1024 + h * 128;
                    bf16_t* qp = Qm + ((size_t)b * T + qb * 256) * 512 + h * 128;
                    attn_unit<128, false>(lds, qp, 512, Kb, Kb + 512, 4096, qp, 4, 0, nullptr, 0, args.in[15] + l * 128, args.in[16] + l * 128);
                } }
            } else if (sp == 8) { if (EN(6)) {
                pg8::Gemm g{(const bf16_t*)(Pr + P_QM), wl + W_CO, M, D, 512}; pg8::StaticOrder S; S.init(M, D, G, bx);
                pg8::EpiResid E{hbuf, hbuf};
                pg8::gemm_phase<pg8::EpiResid, pg8::StaticOrder, true, true>(lds, g, S, E); }
            } else if (sp == 10) { if (EN(9)) {
                pg8::Gemm g{U, wl + W_GU, M, NGU, D}; pg8::StaticOrder S; S.init(M, NGU, G, bx);
                pg8::EpiSwiglu E{(bf16_t*)(Pr + P_ACT)};
                pg8::gemm_phase<pg8::EpiSwiglu, pg8::StaticOrder, true, true>(lds, g, S, E); }
            } else { if (EN(6)) {
                pg8::Gemm g{(const bf16_t*)(Pr + P_ACT), wl + W_DN, M, D, DFF}; pg8::StaticOrder S; S.init(M, D, G, bx);
                pg8::EpiResid E{hbuf, hbuf};
                pg8::gemm_phase<pg8::EpiResid, pg8::StaticOrder, true, true>(lds, g, S, E); }
            }
        }
        if (ph + 1 < args.ph_hi) grid.sync();
    }
}

#ifndef MK_ONE_LAUNCH
#define MK_ONE_LAUNCH 1
#endif
extern "C" void kernel_launch(void* const* d_in, const int* in_sizes, int n_in, void* d_out, int out_size, void* d_ws, size_t ws_size, hipStream_t stream) {
    static int grid = 0;
    if (grid == 0) {
        if (n_in != 21 || out_size != M * D || ws_size < WS_END) { fprintf(stderr, "kernel_launch: unexpected shapes (n_in %d, out %d, ws %zu)\n", n_in, out_size, ws_size); grid = -1; return; }
        if (hipFuncSetAttribute((const void*)fwd_kernel, hipFuncAttributeMaxDynamicSharedMemorySize, LDS_BYTES) != hipSuccess) { fprintf(stderr, "kernel_launch: hipFuncSetAttribute failed\n"); grid = -1; return; }
        int dev = 0, cus = 0, per_cu = 0;
        hipGetDevice(&dev); hipDeviceGetAttribute(&cus, hipDeviceAttributeMultiprocessorCount, dev);
        hipOccupancyMaxActiveBlocksPerMultiprocessor(&per_cu, (const void*)fwd_kernel, 512, LDS_BYTES);
        (void)hipGetLastError();
        if (per_cu < 1) per_cu = 1;
        grid = cus;
        if (grid > 256) grid = 256;
    }
    if (grid < 0) return;
    Args a{};
    for (int i = 0; i < 21; ++i) a.in[i] = (const float*)d_in[i];
    a.out = (float*)d_out; a.ws = (unsigned char*)d_ws;
#if MK_ONE_LAUNCH
    a.ph_lo = 0; a.ph_hi = N_PHASES;
    void* kargs[] = {&a};
    hipError_t e = hipLaunchCooperativeKernel((const void*)fwd_kernel, dim3(grid), dim3(512), kargs, LDS_BYTES, stream);
    if (e != hipSuccess) fprintf(stderr, "cooperative launch failed: %s (grid %d)\n", hipGetErrorString(e), grid);
#else
    for (int ph = 0; ph < N_PHASES; ++ph) { a.ph_lo = ph; a.ph_hi = ph + 1; hipLaunchKernelGGL(fwd_kernel, dim3(grid), dim3(512), LDS_BYTES, stream, a); }
#endif
}
```

```cpp
#include <hip/hip_runtime.h>
#include <hip/hip_cooperative_groups.h>
#include <cstdio>
#include <cstdint>
namespace cg = cooperative_groups;
namespace pg8 {
#define PG8_LAS __attribute__((address_space(3)))
typedef unsigned short bf16_t;
typedef short bf16x8 __attribute__((ext_vector_type(8)));
typedef float f32x4 __attribute__((ext_vector_type(4)));
typedef unsigned u32x4 __attribute__((ext_vector_type(4)));
constexpr int BM = 256, BK = 64, HALF = 128, HTB = HALF * BK * 2  , STAGE_BYTES = 8 * HTB, NXCD = 8, WGM = 8;

__host__ __device__ __forceinline__ int lds_byte(int r, int c) { const int st = (r >> 4) * 2 + (c >> 5), rr = r & 15, cc = c & 31, ob = rr * 64 + cc * 2; return st * 1024 + (ob ^ (((ob >> 9) & 1) << 5)); }
__host__ __device__ __forceinline__ void stage_rc(int b, int& R, int& C) { const int st = b / 1024, sb = b % 1024, swz = sb ^ (((sb >> 9) & 1) << 5); R = (st >> 1) * 16 + swz / 64; C = (st & 1) * 32 + (swz % 64) / 2; }
__host__ __device__ __forceinline__ int perm32(int rho) { const int n = rho >> 4, i = rho & 15; return 8 * (i >> 2) + 4 * n + (i & 3); }

struct Unit { int pm, pn; };
struct Gemm { const bf16_t* A; const bf16_t* Bt; int M, N, K; };

struct StaticOrder {
    int nM, nN, nwg, G, c;
    __host__ __device__ void init(int M, int N, int G_, int c_) { nM = M / BM; nN = N / BM; nwg = nM * nN; G = G_; c = c_; }
    __host__ __device__ bool next(int i, Unit& u) const {
        const long L = (long)i * G + c; if (L >= nwg) return false;
        int wgid = (int)L; { const int q = nwg / NXCD, r = nwg % NXCD, xcd = wgid % NXCD, off = wgid / NXCD; wgid = (xcd < r ? xcd * (q + 1) : r * (q + 1) + (xcd - r) * q) + off; }
        const int nig = WGM * nN, gid = wgid / nig, fm = gid * WGM, gsz = (nM - fm) < WGM ? (nM - fm) : WGM;
        u.pm = fm + ((wgid % nig) % gsz); u.pn = (wgid % nig) / gsz; return true;
    }
    __device__ __forceinline__ void a_ready(const Unit&) const {}
    __device__ __forceinline__ void done(const Unit&) const {}
};

__device__ __forceinline__ unsigned cvt_pk_bf16(float lo, float hi) { unsigned r; asm volatile("v_cvt_pk_bf16_f32 %0, %1, %2" : "=v"(r) : "v"(lo), "v"(hi)); return r; }
__device__ __forceinline__ float bf_lo(unsigned w) { return __uint_as_float(w << 16); }
__device__ __forceinline__ float bf_hi(unsigned w) { return __uint_as_float(w & 0xffff0000u); }
__device__ __forceinline__ u32x4 pack8(const f32x4 v0, const f32x4 v1) { u32x4 w; w.x = cvt_pk_bf16(v0[0], v0[1]); w.y = cvt_pk_bf16(v0[2], v0[3]); w.z = cvt_pk_bf16(v1[0], v1[1]); w.w = cvt_pk_bf16(v1[2], v1[3]); return w; }
__device__ __forceinline__ void unpack8(const u32x4 w, f32x4& v0, f32x4& v1) { v0 = (f32x4){bf_lo(w.x), bf_hi(w.x), bf_lo(w.y), bf_hi(w.y)}; v1 = (f32x4){bf_lo(w.z), bf_hi(w.z), bf_lo(w.w), bf_hi(w.w)}; }
__device__ __forceinline__ float sigmoidf_(float x) { return __builtin_amdgcn_rcpf(1.0f + __builtin_amdgcn_exp2f(-1.4426950408889634f * x)); }

constexpr int MTOK = 16384;
constexpr float QSCALE = 0.125f * 1.4426950408889634f;
constexpr float NEPS = 1e-6f;

struct EpiPlain {
    static constexpr bool PERM = true, AFTER_DRAIN = false;
    bf16_t* O; int ldc;
    __device__ __forceinline__ void operator()(const f32x4 (&acc)[2][2][4][2], const Unit& u, int wr, int wc, int fr, int fq) const {
        const int row0 = u.pm * BM + wr * 64 + fr, col0 = u.pn * BM + wc * 32 + 8 * fq;
#pragma unroll
        for (int ai = 0; ai < 2; ++ai)
#pragma unroll
            for (int m = 0; m < 4; ++m) { bf16_t* rowp = O + (size_t)(row0 + ai * HALF + m * 16) * ldc + col0;
#pragma unroll
                for (int bj = 0; bj < 2; ++bj) *(u32x4*)(rowp + bj * HALF) = pack8(acc[ai][bj][m][0], acc[ai][bj][m][1]); }
    }
};

struct EpiIn {
    static constexpr bool PERM = true, AFTER_DRAIN = false;
    bf16_t* P; const float* qg; const float* kg;
    __device__ __forceinline__ void operator()(const f32x4 (&acc)[2][2][4][2], const Unit& u, int wr, int wc, int fr, int fq) const {
        const int pn = u.pn; int mode, ldc, ct; bf16_t* base;
        if (pn < 12) { const int b = pn >> 1; base = P + (size_t)b * ((size_t)MTOK * 512); ldc = 512; ct = (pn & 1) * 256; mode = (b == 0) ? 1 : (b == 1) ? 2 : 0; }
        else { const int b = (pn - 12) >> 2; base = P + (size_t)6 * MTOK * 512 + (size_t)b * ((size_t)MTOK * 1024); ldc = 1024; ct = ((pn - 12) & 3) * 256; mode = 3; }
        const int row0 = u.pm * BM + wr * 64 + fr, dcol = ct + 64 * wc + 8 * fq;
        f32x4 gv[2][2];
        if (mode == 1 || mode == 2) { const float* g = (mode == 1) ? qg : kg; const float sc = (mode == 1) ? QSCALE : 1.0f;
#pragma unroll
            for (int bj = 0; bj < 2; ++bj)
#pragma unroll
                for (int n = 0; n < 2; ++n) gv[bj][n] = *(const f32x4*)(g + 32 * bj + 8 * fq + 4 * n) * sc; }
#pragma unroll
        for (int ai = 0; ai < 2; ++ai)
#pragma unroll
            for (int m = 0; m < 4; ++m) {
                f32x4 v[2][2];
#pragma unroll
                for (int bj = 0; bj < 2; ++bj)
#pragma unroll
                    for (int n = 0; n < 2; ++n) v[bj][n] = acc[ai][bj][m][n];
                if (mode == 1 || mode == 2) {
                    float ss = 0.f;
#pragma unroll
                    for (int bj = 0; bj < 2; ++bj)
#pragma unroll
                        for (int n = 0; n < 2; ++n) { const f32x4 x = v[bj][n]; ss += (x[0] * x[0] + x[1] * x[1]) + (x[2] * x[2] + x[3] * x[3]); }
                    ss += __shfl_xor(ss, 16); ss += __shfl_xor(ss, 32);
                    const float rs = __builtin_amdgcn_rsqf(ss * (1.0f / 64.0f) + NEPS);
#pragma unroll
                    for (int bj = 0; bj < 2; ++bj)
#pragma unroll
                        for (int n = 0; n < 2; ++n) v[bj][n] = v[bj][n] * rs * gv[bj][n];
                } else if (mode == 3) {
#pragma unroll
                    for (int bj = 0; bj < 2; ++bj)
#pragma unroll
                        for (int n = 0; n < 2; ++n) { f32x4 x = v[bj][n]; x[0] = sigmoidf_(x[0]); x[1] = sigmoidf_(x[1]); x[2] = sigmoidf_(x[2]); x[3] = sigmoidf_(x[3]); v[bj][n] = x; }
                }
                bf16_t* rowp = base + (size_t)(row0 + ai * HALF + m * 16) * ldc + dcol;
#pragma unroll
                for (int bj = 0; bj < 2; ++bj) *(u32x4*)(rowp + 32 * bj) = pack8(v[bj][0], v[bj][1]);
            }
    }
};

template <bool ADD> struct EpiGate {
    static constexpr bool PERM = true, AFTER_DRAIN = false;
    const bf16_t* G; bf16_t* Mg;
    __device__ __forceinline__ void operator()(const f32x4 (&acc)[2][2][4][2], const Unit& u, int wr, int wc, int fr, int fq) const {
        const int row0 = u.pm * BM + wr * 64 + fr, col0 = u.pn * BM + wc * 32 + 8 * fq;
#pragma unroll
        for (int ai = 0; ai < 2; ++ai)
#pragma unroll
            for (int m = 0; m < 4; ++m) { const size_t off = (size_t)(row0 + ai * HALF + m * 16) * 1024 + col0;
#pragma unroll
                for (int bj = 0; bj < 2; ++bj) { f32x4 g0, g1; unpack8(*(const u32x4*)(G + off + bj * HALF), g0, g1);
                    f32x4 r0 = g0 * acc[ai][bj][m][0], r1 = g1 * acc[ai][bj][m][1];
                    if (ADD) { f32x4 p0, p1; unpack8(*(const u32x4*)(Mg + off + bj * HALF), p0, p1); r0 += p0; r1 += p1; }
                    *(u32x4*)(Mg + off + bj * HALF) = pack8(r0, r1); } }
    }
};

struct EpiResid {
    static constexpr bool PERM = false, AFTER_DRAIN = false;
    const float* base; float* out;
    __device__ __forceinline__ void operator()(const f32x4 (&acc)[2][2][4][2], const Unit& u, int wr, int wc, int fr, int fq) const {
        const int row0 = u.pm * BM + wr * 64 + fr, col0 = u.pn * BM + wc * 32 + 4 * fq;
#pragma unroll
        for (int ai = 0; ai < 2; ++ai)
#pragma unroll
            for (int m = 0; m < 4; ++m) { const size_t off = (size_t)(row0 + ai * HALF + m * 16) * 1024 + col0;
#pragma unroll
                for (int bj = 0; bj < 2; ++bj)
#pragma unroll
                    for (int n = 0; n < 2; ++n) { const f32x4 b = *(const f32x4*)(base + off + bj * HALF + n * 16); *(f32x4*)(out + off + bj * HALF + n * 16) = b + acc[ai][bj][m][n]; }
                if (m & 1) asm volatile("" ::: "memory"); }
    }
};

struct EpiSwiglu {
    static constexpr bool PERM = true, AFTER_DRAIN = false;
    bf16_t* O;
    __device__ __forceinline__ void operator()(const f32x4 (&acc)[2][2][4][2], const Unit& u, int wr, int wc, int fr, int fq) const {
        const int row0 = u.pm * BM + wr * 64 + fr, col0 = u.pn * HALF + wc * 32 + 8 * fq;
#pragma unroll
        for (int ai = 0; ai < 2; ++ai)
#pragma unroll
            for (int m = 0; m < 4; ++m) { f32x4 r[2];
#pragma unroll
                for (int n = 0; n < 2; ++n) { const f32x4 g = acc[ai][0][m][n], v = acc[ai][1][m][n];
#pragma unroll
                    for (int e = 0; e < 4; ++e) r[n][e] = g[e] * sigmoidf_(g[e]) * v[e]; }
                *(u32x4*)(O + (size_t)(row0 + ai * HALF + m * 16) * 2816 + col0) = pack8(r[0], r[1]); }
    }
};

template <class Epi, class Sched, bool ALIGN_EPI = false, bool SP2 = false>
__device__ __forceinline__ void gemm_phase(PG8_LAS unsigned char* lds, const Gemm g, const Sched& S, const Epi& E) {
    int tid_ = threadIdx.x; asm volatile("" : "+v"(tid_));
    const int tid = tid_, wid = __builtin_amdgcn_readfirstlane(tid >> 6), lane = tid & 63, wr = wid >> 2, wc = wid & 3, fr = lane & 15, fq = lane >> 4;
    const int K = g.K, nt = K / BK;
    unsigned voffA[2], voffB[2];
#pragma unroll
    for (int i = 0; i < 2; ++i) { int R, C; stage_rc(tid * 16 + i * 8192, R, C); const int Rb = Epi::PERM ? ((R & ~31) + perm32(R & 31)) : R;
        voffA[i] = (unsigned)(R * K + C) * 2u; voffB[i] = (unsigned)(Rb * K + C) * 2u; }
    const size_t kstep = (size_t)(BK * 2);
    const size_t hstep = (size_t)HALF * K * 2;
    const size_t tstep = 2 * hstep;
    const unsigned ldsw = (unsigned)wid * 1024u;
    const int aoff = lds_byte(wr * 64 + fr, fq * 8), boff = lds_byte(wc * 32 + fr, fq * 8);
#define PG8_SA(b, h) (((b) * 2 + (h)) * HTB)
#define PG8_SB(b, h) ((4 + (b) * 2 + (h)) * HTB)
#define PG8_STAGE(bufoff, gbase, voff) do { _Pragma("unroll") for (int _i = 0; _i < 2; ++_i) \
        __builtin_amdgcn_global_load_lds((const unsigned*)((const char*)(gbase) + (voff)[_i]), (PG8_LAS unsigned*)(lds + (bufoff) + ldsw + _i * 8192), 16, 0, 0); } while (0)
#define PG8_LDA(dst, b, h) do { _Pragma("unroll") for (int m = 0; m < 4; ++m) _Pragma("unroll") for (int k = 0; k < 2; ++k) dst[m][k] = *(const PG8_LAS bf16x8*)(lds + PG8_SA(b, h) + aoff + m * 2048 + k * 1024); } while (0)
#define PG8_LDB(dst, b, h) do { _Pragma("unroll") for (int n = 0; n < 2; ++n) _Pragma("unroll") for (int k = 0; k < 2; ++k) dst[n][k] = *(const PG8_LAS bf16x8*)(lds + PG8_SB(b, h) + boff + n * 2048 + k * 1024); } while (0)
#define PG8_MMA(ai, bj, At, Bt) do { __builtin_amdgcn_s_setprio(1); _Pragma("unroll") for (int m = 0; m < 4; ++m) _Pragma("unroll") for (int n = 0; n < 2; ++n) _Pragma("unroll") for (int k = 0; k < 2; ++k) \
        acc[ai][bj][m][n] = __builtin_amdgcn_mfma_f32_16x16x32_bf16(Bt[n][k], At[m][k], acc[ai][bj][m][n], 0, 0, 0); __builtin_amdgcn_s_setprio(0); } while (0)
#define PG8_WAIT_V(n) asm volatile("s_waitcnt vmcnt(" #n ")" ::: "memory")
#define PG8_WAIT_L(n) asm volatile("s_waitcnt lgkmcnt(" #n ")" ::: "memory")
#define PG8_BAR __builtin_amdgcn_s_barrier()
#define PG8_SCHED __builtin_amdgcn_sched_barrier(0)
    Unit cur, nxt; int ui = 0;
    if (!S.next(0, cur)) return;
    f32x4 acc[2][2][4][2];
#pragma unroll
    for (int a = 0; a < 2; ++a)
#pragma unroll
        for (int b = 0; b < 2; ++b)
#pragma unroll
            for (int m = 0; m < 4; ++m)
#pragma unroll
                for (int n = 0; n < 2; ++n) acc[a][b][m][n] = (f32x4){0.f, 0.f, 0.f, 0.f};
    bf16x8 At[4][2], B0[2][2], B1[2][2];
    const char* cA = (const char*)g.A + (size_t)cur.pm * tstep; const char* cB = (const char*)g.Bt + (size_t)cur.pn * tstep;
    S.a_ready(cur);
    if constexpr (SP2) {
        PG8_STAGE(PG8_SB(0, 0), cB, voffB); PG8_STAGE(PG8_SB(0, 1), cB + hstep, voffB); PG8_STAGE(PG8_SA(0, 0), cA, voffA); PG8_STAGE(PG8_SA(0, 1), cA + hstep, voffA);
        if (wr == 1) PG8_BAR;
        PG8_WAIT_V(2); PG8_BAR;
        PG8_STAGE(PG8_SB(1, 0), cB + kstep, voffB); PG8_STAGE(PG8_SA(1, 0), cA + kstep, voffA); PG8_STAGE(PG8_SB(1, 1), cB + hstep + kstep, voffB);
        PG8_WAIT_V(6); PG8_BAR;
    } else {
        PG8_STAGE(PG8_SB(0, 0), cB, voffB); PG8_STAGE(PG8_SA(0, 0), cA, voffA); PG8_STAGE(PG8_SB(0, 1), cB + hstep, voffB); PG8_STAGE(PG8_SA(0, 1), cA + hstep, voffA);
        if (wr == 1) PG8_BAR;
        PG8_WAIT_V(4); PG8_BAR;
        PG8_STAGE(PG8_SB(1, 0), cB + kstep, voffB); PG8_STAGE(PG8_SA(1, 0), cA + kstep, voffA); PG8_STAGE(PG8_SB(1, 1), cB + hstep + kstep, voffB);
        PG8_WAIT_V(6); PG8_BAR;
    }
    for (;;) {
        const bool has_next = S.next(ui + 1, nxt);
        const char* nA = has_next ? (const char*)g.A + (size_t)nxt.pm * tstep : cA; const char* nB = has_next ? (const char*)g.Bt + (size_t)nxt.pn * tstep : cB;
        for (int t = 0; t < nt; t += 2) {
            const bool last = (t == nt - 2);
            const char* a1 = cA + (size_t)(t + 1) * kstep;
            const char* a2 = last ? nA : cA + (size_t)(t + 2) * kstep; const char* b2 = last ? nB : cB + (size_t)(t + 2) * kstep;
            const char* a3 = a2 + kstep; const char* b3 = b2 + kstep;
            if (last && has_next) S.a_ready(nxt);
            if constexpr (SP2) {
            PG8_LDB(B0, 0, 0); PG8_LDB(B1, 0, 1); PG8_SCHED; PG8_LDA(At, 0, 0); PG8_STAGE(PG8_SA(1, 1), a1 + hstep, voffA);
            PG8_WAIT_V(8); PG8_WAIT_L(0); PG8_BAR; PG8_MMA(0, 0, At, B0); PG8_MMA(0, 1, At, B1); PG8_BAR; PG8_SCHED;
            PG8_LDA(At, 0, 1); PG8_STAGE(PG8_SB(0, 0), b2, voffB); PG8_STAGE(PG8_SB(0, 1), b2 + hstep, voffB); PG8_STAGE(PG8_SA(0, 0), a2, voffA);
            PG8_WAIT_V(8); PG8_WAIT_L(0); PG8_BAR; PG8_MMA(1, 0, At, B0); PG8_MMA(1, 1, At, B1); PG8_BAR; PG8_SCHED;
            PG8_LDB(B0, 1, 0); PG8_LDB(B1, 1, 1); PG8_SCHED; PG8_LDA(At, 1, 0); PG8_STAGE(PG8_SA(0, 1), a2 + hstep, voffA);
            PG8_WAIT_V(8); PG8_WAIT_L(0); PG8_BAR; PG8_MMA(0, 0, At, B0); PG8_MMA(0, 1, At, B1); PG8_BAR; PG8_SCHED;
            PG8_LDA(At, 1, 1); PG8_STAGE(PG8_SB(1, 0), b3, voffB); PG8_STAGE(PG8_SB(1, 1), b3 + hstep, voffB); PG8_STAGE(PG8_SA(1, 0), a3, voffA);
            PG8_WAIT_V(8); PG8_WAIT_L(0); PG8_BAR; PG8_MMA(1, 0, At, B0); PG8_MMA(1, 1, At, B1); PG8_BAR; PG8_SCHED;
            } else {
            PG8_LDB(B0, 0, 0); PG8_SCHED; PG8_LDA(At, 0, 0); PG8_STAGE(PG8_SA(1, 1), a1 + hstep, voffA);
            PG8_WAIT_L(8); PG8_BAR; PG8_WAIT_L(0); PG8_MMA(0, 0, At, B0); PG8_BAR; PG8_SCHED;
            PG8_LDB(B1, 0, 1); PG8_STAGE(PG8_SB(0, 0), b2, voffB);
            PG8_BAR; PG8_WAIT_L(0); PG8_MMA(0, 1, At, B1); PG8_BAR;
            PG8_LDA(At, 0, 1); PG8_STAGE(PG8_SA(0, 0), a2, voffA);
            PG8_BAR; PG8_WAIT_L(0); PG8_MMA(1, 0, At, B0); PG8_BAR; PG8_SCHED;
            PG8_STAGE(PG8_SB(0, 1), b2 + hstep, voffB);
            PG8_WAIT_V(6); PG8_BAR; PG8_MMA(1, 1, At, B1); PG8_BAR;
            PG8_LDB(B0, 1, 0); PG8_SCHED; PG8_LDA(At, 1, 0); PG8_STAGE(PG8_SA(0, 1), a2 + hstep, voffA);
            PG8_WAIT_L(8); PG8_BAR; PG8_WAIT_L(0); PG8_MMA(0, 0, At, B0); PG8_BAR; PG8_SCHED;
            PG8_LDB(B1, 1, 1); PG8_STAGE(PG8_SB(1, 0), b3, voffB);
            PG8_BAR; PG8_WAIT_L(0); PG8_MMA(0, 1, At, B1); PG8_BAR;
            PG8_LDA(At, 1, 1); PG8_STAGE(PG8_SA(1, 0), a3, voffA);
            PG8_BAR; PG8_WAIT_L(0); PG8_MMA(1, 0, At, B0); PG8_BAR; PG8_SCHED;
            PG8_STAGE(PG8_SB(1, 1), b3 + hstep, voffB);
            PG8_WAIT_V(6); PG8_BAR; PG8_MMA(1, 1, At, B1); PG8_BAR;
            }
        }
        if constexpr (ALIGN_EPI) { if (wr == 0) PG8_BAR; }
        if constexpr (!Epi::AFTER_DRAIN) { E(acc, cur, wr, wc, fr, fq); S.done(cur); }
        if (!has_next) break;
#pragma unroll
        for (int a = 0; a < 2; ++a)
#pragma unroll
            for (int b = 0; b < 2; ++b)
#pragma unroll
                for (int m = 0; m < 4; ++m)
#pragma unroll
                    for (int n = 0; n < 2; ++n) acc[a][b][m][n] = (f32x4){0.f, 0.f, 0.f, 0.f};
        cur = nxt; cA = nA; cB = nB; ++ui;
        if constexpr (ALIGN_EPI) { if (wr == 1) PG8_BAR; }
    }
    PG8_WAIT_V(0);
    if constexpr (!ALIGN_EPI) { if (wr == 0) PG8_BAR; }
    PG8_BAR;
    if constexpr (Epi::AFTER_DRAIN) { E.fused(acc, cur, wr, wc, fr, fq, lds, wid, lane); S.done(cur); }
#undef PG8_SA
#undef PG8_SB
#undef PG8_STAGE
#undef PG8_LDA
#undef PG8_LDB
#undef PG8_MMA
#undef PG8_WAIT_V
#undef PG8_WAIT_L
#undef PG8_BAR
#undef PG8_SCHED
}
}

#define LAS __attribute__((address_space(3)))
using pg8::bf16_t; using pg8::bf16x8; using pg8::f32x4; using pg8::u32x4;
typedef float f32x16 __attribute__((ext_vector_type(16)));
typedef short v4i16_t __attribute__((ext_vector_type(4)));
typedef unsigned u32x2 __attribute__((ext_vector_type(2)));

constexpr int M = 16384, T = 2048, NBATCH = 8, D = 1024, DEPTH = 4, INW = 5128, NIN = 5120, DFF = 2816, NGU = 5632, MEMT = 256, MROWS = NBATCH * MEMT;
constexpr float LOG2E = 1.4426950408889634f;
constexpr float MSCALE = 0.08838834764831845f * 1.4426950408889634f;
constexpr size_t MiB = 1u << 20;
constexpr size_t WS_LOGF = 1 * MiB;
constexpr size_t WS_CUM = WS_LOGF + 512 * 1024;
constexpr size_t WS_W = 2 * MiB;
constexpr size_t W_IN = 0, W_UA = 5242880, W_UB = 5767168, W_O = 6291456, W_CQ = 7340032, W_CO = 7864320, W_GU = 8388608, W_DN = 14155776, W_LAYER = 17039360;
constexpr size_t WS_U = WS_W + 130 * MiB;
constexpr size_t WS_KVM = WS_U + 32 * MiB;
constexpr size_t WS_P = WS_KVM + 16 * MiB;
constexpr size_t WS_END = WS_P + 160 * MiB;
static_assert(W_LAYER * 2 * 4 == 130 * MiB, "weights");
constexpr size_t P_Q = 0, P_K = 16 * MiB, P_V = 32 * MiB, P_Z = 48 * MiB, P_GB = 64 * MiB, P_GC = 80 * MiB, P_SGA = 96 * MiB, P_SGB = 128 * MiB;
constexpr size_t P_MRG = P_K;
constexpr size_t P_QM = P_Z;
constexpr size_t P_ACT = 0;
constexpr size_t P_MEMHAT = 0;
constexpr size_t P_WCKV = 16 * MiB;
constexpr int LDS_BYTES = 147456;

__device__ __forceinline__ float wave_sum(float v) {
#pragma unroll
    for (int o = 1; o < 64; o <<= 1) v += __shfl_xor(v, o);
    return v;
}
__device__ __forceinline__ unsigned pk2(float lo, float hi) { return pg8::cvt_pk_bf16(lo, hi); }

__device__ __forceinline__ int srcmap(int map, int n) {
    if (map == 1) { const int tile = n >> 8, c = n & 255; const int o = tile * 256 + 64 * ((c >> 5) & 3) + 32 * (c >> 7) + (c & 31); return o >= 1536 ? o + 8 : o; }
    if (map == 2) { const int tile = n >> 8, c = n & 255; return c < 128 ? tile * 128 + c : DFF + tile * 128 + (c - 128); }
    return n;
}
__device__ __forceinline__ void cvt_item(const float* W, int K, int Nsrc, int nblk, bf16_t* dst, int map, const float* gain, LAS float* scr, int item, int lane) {
    const int kb = item / nblk, nb = item % nblk, k0 = 64 * kb, n0 = 64 * nb;
    const int sc = srcmap(map, n0 + lane);
    const float* src = W + (size_t)k0 * Nsrc + sc;
#pragma unroll 8
    for (int i = 0; i < 64; ++i) { float v = src[(size_t)i * Nsrc]; if (gain) v *= gain[k0 + i]; scr[i * 65 + lane] = v; }
    asm volatile("s_waitcnt lgkmcnt(0)" ::: "memory");
    const int c = lane & 7;
#pragma unroll
    for (int j = 0; j < 8; ++j) { const int n = (lane >> 3) + 8 * j; const LAS float* s = scr + (8 * c) * 65 + n;
        u32x4 o; o.x = pk2(s[0], s[65]); o.y = pk2(s[2 * 65], s[3 * 65]); o.z = pk2(s[4 * 65], s[5 * 65]); o.w = pk2(s[6 * 65], s[7 * 65]);
        *(u32x4*)(dst + (size_t)(n0 + n) * K + k0 + 8 * c) = o; }
    asm volatile("s_waitcnt lgkmcnt(0)" ::: "memory");
}
struct CvtJob { const float* W; int K, Nsrc, Ndst, map; bf16_t* dst; const float* gain; };

template <bool FLOGIT>
__device__ __forceinline__ void norm_rows(const float* src, const float* gain, bf16_t* dst, int nrows, int gw, int NGW, int lane, LAS const float* wf, const float* bf, float* logf) {
    f32x4 gv[4];
#pragma unroll
    for (int j = 0; j < 4; ++j) gv[j] = gain ? ((const f32x4*)gain)[lane + 64 * j] : (f32x4){1.f, 1.f, 1.f, 1.f};
    for (int row = gw; row < nrows; row += NGW) {
        const f32x4* xr = (const f32x4*)(src + (size_t)row * D) + lane;
        f32x4 v[4]; float ss = 0.f;
#pragma unroll
        for (int j = 0; j < 4; ++j) { v[j] = xr[64 * j]; ss += (v[j][0] * v[j][0] + v[j][1] * v[j][1]) + (v[j][2] * v[j][2] + v[j][3] * v[j][3]); }
        const float rstd = 1.0f / sqrtf(wave_sum(ss) * (1.0f / D) + 1e-6f);
        u32x2* o8 = (u32x2*)(dst + (size_t)row * D) + lane;
#pragma unroll
        for (int j = 0; j < 4; ++j) { v[j] = v[j] * rstd * gv[j]; u32x2 w; w.x = pk2(v[j][0], v[j][1]); w.y = pk2(v[j][2], v[j][3]); o8[64 * j] = w; }
        if (FLOGIT) {
            float a[8];
#pragma unroll
            for (int i = 0; i < 8; ++i) a[i] = 0.f;
#pragma unroll
            for (int j = 0; j < 4; ++j)
#pragma unroll
                for (int e = 0; e < 4; ++e) { const LAS f32x4* wp = (const LAS f32x4*)(wf + ((j * 4 + e) * 64 + lane) * 8); const f32x4 w0 = wp[0], w1 = wp[1]; const float x = v[j][e];
                    a[0] += x * w0[0]; a[1] += x * w0[1]; a[2] += x * w0[2]; a[3] += x * w0[3]; a[4] += x * w1[0]; a[5] += x * w1[1]; a[6] += x * w1[2]; a[7] += x * w1[3]; }
            float mine = 0.f;
#pragma unroll
            for (int i = 0; i < 8; ++i) { const float s = wave_sum(a[i]); if (lane == i) mine = s; }
            if (lane < 8) { const float x = mine + bf[lane]; logf[(size_t)row * 8 + lane] = fminf(x, 0.f) - log1pf(expf(-fabsf(x))); }
        }
    }
}

__device__ __forceinline__ int crow(int r, int hi) { return (r & 3) + 8 * (r >> 2) + 4 * hi; }
template <int HD, bool FOX>
__device__ __forceinline__ void attn_unit(LAS unsigned char* lds, const bf16_t* Qb, int ldq, const bf16_t* Kb, const bf16_t* Vb, int ldk, bf16_t* Ob, int nkt, int tband, const float* cp, int q0, const float* qgain, const float* kgain) {
    constexpr int KS = HD / 16, DB = HD / 32, NCH = HD / 64, KP = HD * 2 + 16, KBUF = 64 * KP, VBUF = DB * 4096;
    constexpr int OFF_K = 0, OFF_V = 2 * KBUF, OFF_CK = OFF_V + 2 * VBUF, OFF_WS = OFF_CK + 512;
    int tid_ = threadIdx.x; asm volatile("" : "+v"(tid_));
    const int tid = tid_, lane = tid & 63, wid = __builtin_amdgcn_readfirstlane(tid >> 6), r32 = lane & 31, hi = lane >> 5;
    LAS float* wsf = (LAS float*)(lds + OFF_WS) + wid * 64;
    bf16x8 qr[KS];
    { const bf16_t* qrow = Qb + (size_t)(wid * 32 + r32) * ldq + hi * 8;
#pragma unroll
      for (int ks = 0; ks < KS; ++ks) qr[ks] = *(const bf16x8*)(qrow + ks * 16);
      if (!FOX) {
          float ss = 0.f;
#pragma unroll
          for (int ks = 0; ks < KS; ++ks)
#pragma unroll
              for (int e = 0; e < 8; ++e) { const float x = __uint_as_float(((unsigned)(unsigned short)qr[ks][e]) << 16); ss += x * x; }
          ss += __shfl_xor(ss, 32);
          const float rs = MSCALE / sqrtf(ss * (1.0f / HD) + 1e-6f);
#pragma unroll
          for (int ks = 0; ks < KS; ++ks) { const f32x4 g0 = *(const f32x4*)(qgain + ks * 16 + hi * 8), g1 = *(const f32x4*)(qgain + ks * 16 + hi * 8 + 4); u32x4 w;
              float x[8];
#pragma unroll
              for (int e = 0; e < 8; ++e) x[e] = __uint_as_float(((unsigned)(unsigned short)qr[ks][e]) << 16) * rs * (e < 4 ? g0[e & 3] : g1[e & 3]);
              w.x = pk2(x[0], x[1]); w.y = pk2(x[2], x[3]); w.z = pk2(x[4], x[5]); w.w = pk2(x[6], x[7]); qr[ks] = __builtin_bit_cast(bf16x8, w); }
      } }
    const float cq = FOX ? cp[q0 + wid * 32 + r32] : 0.f;
    const int skey = tid >> 3, sch = tid & 7;
    u32x4 kreg[NCH], vreg[NCH]; float ckreg = 0.f;
    f32x4 kg0[NCH], kg1[NCH];
    if (!FOX) {
#pragma unroll
        for (int i = 0; i < NCH; ++i) { kg0[i] = *(const f32x4*)(kgain + (sch + 8 * i) * 8); kg1[i] = *(const f32x4*)(kgain + (sch + 8 * i) * 8 + 4); }
    }
#define ATT_LOAD(t) do { _Pragma("unroll") for (int i_ = 0; i_ < NCH; ++i_) { const size_t go_ = (size_t)((t) * 64 + skey) * ldk + (sch + 8 * i_) * 8; kreg[i_] = *(const u32x4*)(Kb + go_); vreg[i_] = *(const u32x4*)(Vb + go_); } \
        if (FOX && tid < 64) ckreg = cp[(t) * 64 + tid]; } while (0)
#define ATT_STORE(buf) do { \
        if (!FOX) { float ss_ = 0.f; f32x4 a_[NCH][2]; _Pragma("unroll") for (int i_ = 0; i_ < NCH; ++i_) { pg8::unpack8(kreg[i_], a_[i_][0], a_[i_][1]); \
              _Pragma("unroll") for (int h_ = 0; h_ < 2; ++h_) ss_ += (a_[i_][h_][0] * a_[i_][h_][0] + a_[i_][h_][1] * a_[i_][h_][1]) + (a_[i_][h_][2] * a_[i_][h_][2] + a_[i_][h_][3] * a_[i_][h_][3]); } \
            ss_ += __shfl_xor(ss_, 1); ss_ += __shfl_xor(ss_, 2); ss_ += __shfl_xor(ss_, 4); const float rs_ = 1.0f / sqrtf(ss_ * (1.0f / HD) + 1e-6f); \
            _Pragma("unroll") for (int i_ = 0; i_ < NCH; ++i_) kreg[i_] = pg8::pack8(a_[i_][0] * rs_ * kg0[i_], a_[i_][1] * rs_ * kg1[i_]); } \
        _Pragma("unroll") for (int i_ = 0; i_ < NCH; ++i_) { const int c_ = sch + 8 * i_; \
            *(LAS u32x4*)(lds + OFF_K + (buf) * KBUF + skey * KP + c_ * 16) = kreg[i_]; \
            *(LAS u32x4*)(lds + OFF_V + (buf) * VBUF + (c_ >> 2) * 4096 + (skey >> 3) * 512 + (skey & 7) * 64 + (c_ & 3) * 16) = vreg[i_]; } \
        if (FOX && tid < 64) *(LAS float*)(lds + OFF_CK + (buf) * 256 + tid * 4) = ckreg; } while (0)
    float mrun = -INFINITY, lrun = 0.f;
    f32x16 o[DB];
#pragma unroll
    for (int d = 0; d < DB; ++d)
#pragma unroll
        for (int r = 0; r < 16; ++r) o[d][r] = 0.f;
    ATT_LOAD(nkt - 1); ATT_STORE(0);
    __syncthreads();
    const int thi = tband + (wid >> 1);
    const int vlane = ((lane >> 4) & 1) * 32 + (lane & 3) * 8 + (4 * hi + ((lane & 15) >> 2)) * 64;
    for (int it = 0; it < nkt; ++it) {
        const int t = nkt - 1 - it, cur = it & 1;
        if (it + 1 < nkt) ATT_LOAD(t - 1);
        if (!FOX || t <= thi) {
            f32x16 p0, p1;
#pragma unroll
            for (int r = 0; r < 16; ++r) { p0[r] = cq; p1[r] = cq; }
            const LAS unsigned char* kb = lds + OFF_K + cur * KBUF + r32 * KP + hi * 16;
#pragma unroll
            for (int ks = 0; ks < KS; ++ks) { const bf16x8 b0 = *(const LAS bf16x8*)(kb + ks * 32), b1 = *(const LAS bf16x8*)(kb + 32 * KP + ks * 32);
                p0 = __builtin_amdgcn_mfma_f32_32x32x16_bf16(b0, qr[ks], p0, 0, 0, 0); p1 = __builtin_amdgcn_mfma_f32_32x32x16_bf16(b1, qr[ks], p1, 0, 0, 0); }
            if (FOX) {
                const LAS float* ckp = (const LAS float*)(lds + OFF_CK + cur * 256) + 4 * hi;
#pragma unroll
                for (int g = 0; g < 4; ++g) { const f32x4 a = *(const LAS f32x4*)(ckp + 8 * g), b = *(const LAS f32x4*)(ckp + 32 + 8 * g);
#pragma unroll
                    for (int e = 0; e < 4; ++e) { p0[4 * g + e] -= a[e]; p1[4 * g + e] -= b[e]; } }
                if (t == thi) { const int qrel = 32 * (wid & 1) + r32;
#pragma unroll
                    for (int r = 0; r < 16; ++r) { const int kv = crow(r, hi); if (kv > qrel) p0[r] = -INFINITY; if (kv + 32 > qrel) p1[r] = -INFINITY; } }
            }
            float rm = fmaxf(p0[0], p1[0]);
#pragma unroll
            for (int r = 1; r < 16; ++r) rm = fmaxf(rm, fmaxf(p0[r], p1[r]));
            rm = fmaxf(rm, __shfl_xor(rm, 32));
            const float mn = fmaxf(mrun, rm);
            if (__any(mn > mrun)) {
                const float al = __builtin_amdgcn_exp2f(mrun - mn); lrun *= al; mrun = mn;
                if (hi == 0) wsf[r32] = al;
                asm volatile("s_waitcnt lgkmcnt(0)" ::: "memory");
#pragma unroll
                for (int g = 0; g < 4; ++g) { const f32x4 a = *(const LAS f32x4*)(wsf + 8 * g + 4 * hi);
#pragma unroll
                    for (int d = 0; d < DB; ++d)
#pragma unroll
                        for (int e = 0; e < 4; ++e) o[d][4 * g + e] *= a[e]; }
            }
            float sacc = 0.f;
#pragma unroll
            for (int r = 0; r < 16; ++r) { p0[r] = __builtin_amdgcn_exp2f(p0[r] - mrun); p1[r] = __builtin_amdgcn_exp2f(p1[r] - mrun); sacc += p0[r] + p1[r]; }
            lrun += sacc;
            bf16x8 pw[4];
#pragma unroll
            for (int j = 0; j < 2; ++j) { u32x4 w0, w1;
                w0.x = pk2(p0[8 * j + 0], p0[8 * j + 1]); w0.y = pk2(p0[8 * j + 2], p0[8 * j + 3]); w0.z = pk2(p0[8 * j + 4], p0[8 * j + 5]); w0.w = pk2(p0[8 * j + 6], p0[8 * j + 7]);
                w1.x = pk2(p1[8 * j + 0], p1[8 * j + 1]); w1.y = pk2(p1[8 * j + 2], p1[8 * j + 3]); w1.z = pk2(p1[8 * j + 4], p1[8 * j + 5]); w1.w = pk2(p1[8 * j + 6], p1[8 * j + 7]);
                pw[j] = __builtin_bit_cast(bf16x8, w0); pw[2 + j] = __builtin_bit_cast(bf16x8, w1); }
            const LAS unsigned char* vb = lds + OFF_V + cur * VBUF + vlane;
#pragma unroll
            for (int d = 0; d < DB; ++d)
#pragma unroll
                for (int j = 0; j < 4; ++j) {
                    const v4i16_t lo = __builtin_amdgcn_ds_read_tr16_b64_v4i16((LAS v4i16_t*)(vb + d * 4096 + j * 1024));
                    const v4i16_t hh = __builtin_amdgcn_ds_read_tr16_b64_v4i16((LAS v4i16_t*)(vb + d * 4096 + j * 1024 + 512));
                    const bf16x8 vf = (bf16x8){lo[0], lo[1], lo[2], lo[3], hh[0], hh[1], hh[2], hh[3]};
                    o[d] = __builtin_amdgcn_mfma_f32_32x32x16_bf16(pw[j], vf, o[d], 0, 0, 0);
                }
        }
        if (it + 1 < nkt) ATT_STORE(cur ^ 1);
        __syncthreads();
    }
#undef ATT_LOAD
#undef ATT_STORE
    lrun += __shfl_xor(lrun, 32);
    if (hi == 0) wsf[32 + r32] = lrun;
    asm volatile("s_waitcnt lgkmcnt(0)" ::: "memory");
    bf16_t* orow = Ob + (size_t)(wid * 32) * ldq + r32;
#pragma unroll
    for (int g = 0; g < 4; ++g) { const f32x4 lv = *(const LAS f32x4*)(wsf + 32 + 8 * g + 4 * hi);
#pragma unroll
        for (int e = 0; e < 4; ++e) { const float il = 1.0f / lv[e]; const int rr = crow(4 * g + e, hi);
#pragma unroll
            for (int d = 0; d < DB; ++d) orow[(size_t)rr * ldq + d * 32] = (bf16_t)(pk2(o[d][4 * g + e] * il, 0.f) & 0xffffu); } }
}

#define XB_TMO      128
#define XB_XCNT(j)  (256  + 64 * (j))
#define XB_XSUB(j)  (1280 + 64 * (j))
#define XB_XGEN(j)  (2304 + 64 * (j))
#define XB_TOP      3328
#define XB_TOPGEN   3392
#define XCD_BAR_WORDS 3456
#define XB_SPIN_CAP (1u << 18)

__device__ __forceinline__ unsigned xb_ld(unsigned* p)              { return __hip_atomic_load(p, __ATOMIC_RELAXED, __HIP_MEMORY_SCOPE_AGENT); }
__device__ __forceinline__ unsigned xb_add(unsigned* p, unsigned v) { return __hip_atomic_fetch_add(p, v, __ATOMIC_RELAXED, __HIP_MEMORY_SCOPE_AGENT); }
__device__ __forceinline__ unsigned xb_xcc_id() { return (unsigned)__builtin_amdgcn_s_getreg((3 << 11) | 20) & 0xFu; }
#define XB_SPIN(cond, bar) do { unsigned _sp = 0; while (cond) { __builtin_amdgcn_s_sleep(1); \
    if ((++_sp & 255u) == 0u) { if (xb_ld(&(bar)[XB_TMO])) break; if (_sp > XB_SPIN_CAP) { atomicAdd(&(bar)[XB_TMO], 1u); break; } } } } while (0)

struct XcdBarrier {
    unsigned* bar; unsigned x;
    volatile LAS unsigned* st;
};

__device__ __forceinline__ XcdBarrier xcd_barrier_post(unsigned* bar, volatile LAS unsigned* st) {
    XcdBarrier b; b.bar = bar; b.x = xb_xcc_id(); b.st = st;
    if (threadIdx.x == 0) (void)xb_add(&bar[XB_XCNT(b.x)], 1u);
    return b;
}
__device__ __forceinline__ void xcd_barrier_complete(unsigned* bar, unsigned x, unsigned& nloc, unsigned& nx) {
    const unsigned G = gridDim.x * gridDim.y * gridDim.z;
    unsigned sum, cnt, mine, sp = 0u;
    for (;;) {
        sum = 0u; cnt = 0u; mine = 0u;
#pragma unroll
        for (unsigned j = 0; j < 16; ++j) { const unsigned c = xb_ld(&bar[XB_XCNT(j)]); sum += c; cnt += (c > 0u) ? 1u : 0u; mine = (j == x) ? c : mine; }
        if (sum == G) break;
        __builtin_amdgcn_s_sleep(1);
        if ((++sp & 255u) == 0u) { if (xb_ld(&bar[XB_TMO])) break; if (sp > XB_SPIN_CAP) { atomicAdd(&bar[XB_TMO], 1u); break; } }
    }
    nloc = mine > 0u ? mine : 1u; nx = cnt > 0u ? cnt : 1u;
}

__device__ __forceinline__ void xcd_barrier(const XcdBarrier& b) {
    asm volatile("s_waitcnt vmcnt(0)" ::: "memory");
    __syncthreads();
    if (threadIdx.x == 0) {
        unsigned* bar = b.bar;
        __builtin_amdgcn_s_waitcnt(0);
        unsigned nloc = b.st[0], nx = b.st[1];
        if (nloc == 0u) { xcd_barrier_complete(bar, b.x, nloc, nx); b.st[0] = nloc; b.st[1] = nx; }
        const unsigned old = xb_add(&bar[XB_XSUB(b.x)], 1u);
        const unsigned gen = old / nloc;
        if (old + 1u == (gen + 1u) * nloc) {
            __builtin_amdgcn_fence(__ATOMIC_RELEASE, "agent");
            asm volatile("s_waitcnt vmcnt(0)" ::: "memory");
            const unsigned og = xb_add(&bar[XB_TOP], 1u);
            const unsigned tg = og / nx;
            if (og + 1u == (tg + 1u) * nx) xb_add(&bar[XB_TOPGEN], 1u);
            else XB_SPIN(xb_ld(&bar[XB_TOPGEN]) == tg, bar);
            __builtin_amdgcn_fence(__ATOMIC_ACQUIRE, "agent");
            xb_add(&bar[XB_XGEN(b.x)], 1u);
            asm volatile("s_waitcnt vmcnt(0)" ::: "memory");
        } else {
            XB_SPIN(xb_ld(&bar[XB_XGEN(b.x)]) == gen, bar);
            __builtin_amdgcn_fence(__ATOMIC_ACQUIRE, "agent");
            asm volatile("s_waitcnt vmcnt(0)" ::: "memory");
        }
    }
    __syncthreads();
}

#ifndef PH_MASK
#define PH_MASK 0xffff
#endif
#define EN(k) (((PH_MASK) >> (k)) & 1)
#ifndef REP_MASK
#define REP_MASK 0
#endif
#define REPS(k) (1 + (((REP_MASK) >> (k)) & 1))
struct Args { const float* in[21]; float* out; unsigned char* ws; int ph_lo, ph_hi; };
constexpr int N_PHASES = 2 + 12 * DEPTH;

__global__ void __launch_bounds__(512, 2) fwd_kernel(Args args) {
    extern __shared__ __attribute__((aligned(16))) unsigned char lds_raw[];
    LAS unsigned char* lds = (LAS unsigned char*)lds_raw;
    const int wave = __builtin_amdgcn_readfirstlane(threadIdx.x >> 6);
    const int G = gridDim.x, bx = blockIdx.x;
    const int vcu = (G % 8 == 0) ? (bx % 8) * (G / 8) + bx / 8 : bx;
    const int gw = vcu * 8 + wave, NGW = G * 8;
    unsigned char* ws = args.ws;
    const float* x_in = args.in[0]; const float* mem = args.in[1];
    float* hbuf = args.out;
    bf16_t* Wb = (bf16_t*)(ws + WS_W);
    bf16_t* U = (bf16_t*)(ws + WS_U);
    bf16_t* KVM = (bf16_t*)(ws + WS_KVM);
    unsigned char* Pr = ws + WS_P;
    float* logf = (float*)(ws + WS_LOGF);
    float* cum = (float*)(ws + WS_CUM);
    cg::grid_group grid = cg::this_grid();
    volatile LAS unsigned* bst = (volatile LAS unsigned*)(lds + (LDS_BYTES - 64));
    if (threadIdx.x < 16) ((LAS unsigned*)(lds + (LDS_BYTES - 64)))[threadIdx.x] = 0u;
    __syncthreads();
    XcdBarrier xbar = xcd_barrier_post((unsigned*)ws, bst);
    if (args.ph_hi > 100000) grid.sync();

    for (int ph = args.ph_lo; ph < args.ph_hi; ++ph) {
        int tid_ = threadIdx.x; asm volatile("" : "+v"(tid_));
        const int tid = tid_, lane = tid & 63;
        if (ph == 0) { if (EN(0)) {
            LAS float* scr = (LAS float*)lds + wave * (64 * 65);
            int pre = 0;
            for (int l = 0; l < DEPTH; ++l) {
                bf16_t* wl = Wb + (size_t)l * W_LAYER;
                for (int j = 0; j < 9; ++j) {
                    CvtJob jb;
                    switch (j) {
                    case 0: jb = CvtJob{args.in[3] + (size_t)l * D * INW, D, INW, NIN, 1, wl + W_IN, nullptr}; break;
                    case 1: jb = CvtJob{args.in[8] + (size_t)l * 512 * D, 512, D, D, 0, wl + W_UA, nullptr}; break;
                    case 2: jb = CvtJob{args.in[9] + (size_t)l * 512 * D, 512, D, D, 0, wl + W_UB, nullptr}; break;
                    case 3: jb = CvtJob{args.in[10] + (size_t)l * D * D, D, D, D, 0, wl + W_O, nullptr}; break;
                    case 4: jb = CvtJob{args.in[13] + (size_t)l * D * 512, D, 512, 512, 0, wl + W_CQ, nullptr}; break;
                    case 5: jb = CvtJob{args.in[14] + (size_t)l * D * 1024, D, 1024, 1024, 0, (bf16_t*)(Pr + P_WCKV) + (size_t)l * 1024 * D, args.in[12] + (size_t)l * D}; break;
                    case 6: jb = CvtJob{args.in[17] + (size_t)l * 512 * D, 512, D, D, 0, wl + W_CO, nullptr}; break;
                    case 7: jb = CvtJob{args.in[19] + (size_t)l * D * NGU, D, NGU, NGU, 2, wl + W_GU, nullptr}; break;
                    default: jb = CvtJob{args.in[20] + (size_t)l * DFF * D, DFF, D, D, 0, wl + W_DN, nullptr}; break;
                    }
                    const int nblk = jb.Ndst / 64, nitems = (jb.K / 64) * nblk;
                    int start = (gw - pre % NGW + NGW) % NGW;
                    for (int it = start; it < nitems; it += NGW) cvt_item(jb.W, jb.K, jb.Nsrc, nblk, jb.dst, jb.map, jb.gain, scr, it, lane);
                    pre += nitems;
                }
            }
            norm_rows<false>(mem, nullptr, (bf16_t*)(Pr + P_MEMHAT), MROWS, gw, NGW, lane, nullptr, nullptr, nullptr); }
        } else if (ph == 1) { if (EN(1)) {
            pg8::Gemm g{(const bf16_t*)(Pr + P_MEMHAT), (const bf16_t*)(Pr + P_WCKV), MROWS, 4096, D}; pg8::StaticOrder S; S.init(MROWS, 4096, G, bx);
            pg8::EpiPlain E{KVM, 4096};
            for (int rep = 0; rep < REPS(1); ++rep) pg8::gemm_phase<pg8::EpiPlain, pg8::StaticOrder, true, true>(lds, g, S, E); }
        } else {
            const int l = (ph - 2) / 12, sp = (ph - 2) % 12;
            const bf16_t* wl = Wb + (size_t)l * W_LAYER;
            const float* hin = (l == 0 && sp <= 4) ? x_in : hbuf;
            if (sp == 0 || sp == 5 || sp == 9) { if (EN(2)) for (int rep = 0; rep < REPS(2); ++rep) {
                if (sp == 0) {
                    const float* wf_src = args.in[3] + (size_t)l * D * INW + 1536;
                    LAS float* wf = (LAS float*)lds;
                    for (int i = tid; i < 1024 * 8; i += 512) { const int k = i >> 3, c = i & 7; const int j = k >> 8, ln = (k & 255) >> 2, e = k & 3; wf[((j * 4 + e) * 64 + ln) * 8 + c] = wf_src[(size_t)k * INW + c]; }
                    __syncthreads();
                    norm_rows<true>(hin, args.in[2] + (size_t)l * D, U, M, gw, NGW, lane, wf, args.in[4] + l * 8, logf);
                    __syncthreads();
                } else {
                    norm_rows<false>(hin, (sp == 5 ? args.in[11] : args.in[18]) + (size_t)l * D, U, M, gw, NGW, lane, nullptr, nullptr, nullptr);
                } }
            } else if (sp == 1) { if (EN(3)) {
                if (bx < NBATCH) {
                    const float* src = logf + ((size_t)bx * T + 32 * lane) * 8 + wave;
                    float xs[32]; float run = 0.f;
#pragma unroll
                    for (int i = 0; i < 32; ++i) { run += src[i * 8]; xs[i] = run; }
                    float inc = run;
#pragma unroll
                    for (int o = 1; o < 64; o <<= 1) { const float y = __shfl_up(inc, o); if (lane >= o) inc += y; }
                    const float excl = inc - run;
                    float* dstc = cum + ((size_t)(bx * 8 + wave)) * T + 32 * lane;
#pragma unroll
                    for (int i = 0; i < 32; ++i) dstc[i] = (excl + xs[i]) * LOG2E;
                }
                pg8::Gemm g{U, wl + W_IN, M, NIN, D}; pg8::StaticOrder S; S.init(M, NIN, G, bx);
                pg8::EpiIn E{(bf16_t*)Pr, args.in[5] + l * 64, args.in[6] + l * 64};
                for (int rep = 0; rep < REPS(3); ++rep) pg8::gemm_phase<pg8::EpiIn, pg8::StaticOrder, true, true>(lds, g, S, E); }
            } else if (sp == 2) { if (EN(4)) {
                bf16_t* Qb = (bf16_t*)(Pr + P_Q); const bf16_t* Kb = (const bf16_t*)(Pr + P_K); const bf16_t* Vb = (const bf16_t*)(Pr + P_V);
                for (int rep = 0; rep < REPS(4); ++rep)
                for (int v = vcu; v < 256; v += G) {
                    const int bh = v >> 2, s = v & 3, b = bh >> 3, h = bh & 7;
                    for (int half = 0; half < 2; ++half) {
                        const int qb = half ? 7 - s : s;
                        const size_t rb = (size_t)b * T;
                        attn_unit<64, true>(lds, Qb + (rb + qb * 256) * 512 + h * 64, 512, Kb + rb * 512 + h * 64, Vb + rb * 512 + h * 64, 512, (rep + 1 < REPS(4) ? U : Qb) + (rb + qb * 256) * 512 + h * 64,
                                            4 * (qb + 1), 4 * qb, cum + (size_t)bh * T, qb * 256, nullptr, nullptr);
                    }
                }
                {
                    const bf16_t* Zb = (const bf16_t*)(Pr + P_Z); bf16_t* GBb = (bf16_t*)(Pr + P_GB); const bf16_t* GCb = (const bf16_t*)(Pr + P_GC);
                    const float* cw = args.in[7] + (size_t)l * 3 * 512 + lane * 8;
                    f32x4 w0a = *(const f32x4*)(cw), w0b = *(const f32x4*)(cw + 4), w1a = *(const f32x4*)(cw + 512), w1b = *(const f32x4*)(cw + 516), w2a = *(const f32x4*)(cw + 1024), w2b = *(const f32x4*)(cw + 1028);
                    for (int item = gw; item < M / 8; item += NGW) {
                        const int r0 = item * 8; const size_t eo = (size_t)r0 * 512 + lane * 8;
                        f32x4 xm2a = {0.f, 0.f, 0.f, 0.f}, xm2b = xm2a, xm1a = xm2a, xm1b = xm2a;
                        if ((r0 & (T - 1)) != 0) { f32x4 za, zb, ca, cb;
                            pg8::unpack8(*(const u32x4*)(Zb + eo - 1024), za, zb); pg8::unpack8(*(const u32x4*)(GCb + eo - 1024), ca, cb); xm2a = za * ca; xm2b = zb * cb;
                            pg8::unpack8(*(const u32x4*)(Zb + eo - 512), za, zb); pg8::unpack8(*(const u32x4*)(GCb + eo - 512), ca, cb); xm1a = za * ca; xm1b = zb * cb; }
#pragma unroll
                        for (int i = 0; i < 8; ++i) { f32x4 za, zb, ca, cb, ga, gb2;
                            pg8::unpack8(*(const u32x4*)(Zb + eo + i * 512), za, zb); pg8::unpack8(*(const u32x4*)(GCb + eo + i * 512), ca, cb); pg8::unpack8(*(const u32x4*)(GBb + eo + i * 512), ga, gb2);
                            const f32x4 xa = za * ca, xb = zb * cb;
                            const f32x4 ya = ga * (w0a * xm2a + w1a * xm1a + w2a * xa), yb = gb2 * (w0b * xm2b + w1b * xm1b + w2b * xb);
                            *(u32x4*)(GBb + eo + i * 512) = pg8::pack8(ya, yb);
                            xm2a = xm1a; xm2b = xm1b; xm1a = xa; xm1b = xb; }
                    }
                } }
            } else if (sp == 3) { if (EN(5)) for (int rep = 0; rep < REPS(5); ++rep) {
                pg8::StaticOrder S; S.init(M, D, G, bx);
                { pg8::Gemm g{(const bf16_t*)(Pr + P_Q), wl + W_UA, M, D, 512}; pg8::EpiGate<false> E{(const bf16_t*)(Pr + P_SGA), (bf16_t*)(Pr + P_MRG)};
                  pg8::gemm_phase<pg8::EpiGate<false>, pg8::StaticOrder, true, true>(lds, g, S, E); }
                { pg8::Gemm g{(const bf16_t*)(Pr + P_GB), wl + W_UB, M, D, 512}; pg8::EpiGate<true> E{(const bf16_t*)(Pr + P_SGB), (bf16_t*)(Pr + P_MRG)};
                  pg8::gemm_phase<pg8::EpiGate<true>, pg8::StaticOrder, true, true>(lds, g, S, E); } }
            } else if (sp == 4) { if (EN(6)) {
                pg8::Gemm g{(const bf16_t*)(Pr + P_MRG), wl + W_O, M, D, D}; pg8::StaticOrder S; S.init(M, D, G, bx);
                for (int rep = 0; rep < REPS(6); ++rep) { pg8::EpiResid E{hin, rep + 1 < REPS(6) ? (float*)(Pr + P_SGA) : hbuf};
                pg8::gemm_phase<pg8::EpiResid, pg8::StaticOrder, true, true>(lds, g, S, E); } }
            } else if (sp == 6) { if (EN(7)) {
                pg8::Gemm g{U, wl + W_CQ, M, 512, D}; pg8::StaticOrder S; S.init(M, 512, G, bx);
                pg8::EpiPlain E{(bf16_t*)(Pr + P_QM), 512};
                for (int rep = 0; rep < REPS(7); ++rep) pg8::gemm_phase<pg8::EpiPlain, pg8::StaticOrder, true, true>(lds, g, S, E); }
            } else if (sp == 7) { if (EN(8)) {
                bf16_t* Qm = (bf16_t*)(Pr + P_QM);
                for (int rep = 0; rep < REPS(8); ++rep)
                for (int v = vcu; v < 256; v += G) {
                    const int b = v >> 5, h = (v >> 3) & 3, qb = v & 7;
                    const bf16_t* Kb = KVM + (size_t)b * MEMT * 4096 + l * 1024 + h * 128;
                    bf16_t* qp = Qm + ((size_t)b * T + qb * 256) * 512 + h * 128;
                    attn_unit<128, false>(lds, qp, 512, Kb, Kb + 512, 4096, (rep + 1 < REPS(8)) ? U + (qp - Qm) : qp, 4, 0, nullptr, 0, args.in[15] + l * 128, args.in[16] + l * 128);
                } }
            } else if (sp == 8) { if (EN(6)) {
                pg8::Gemm g{(const bf16_t*)(Pr + P_QM), wl + W_CO, M, D, 512}; pg8::StaticOrder S; S.init(M, D, G, bx);
                for (int rep = 0; rep < REPS(6); ++rep) { pg8::EpiResid E{hbuf, rep + 1 < REPS(6) ? (float*)(Pr + P_SGA) : hbuf};
                pg8::gemm_phase<pg8::EpiResid, pg8::StaticOrder, true, true>(lds, g, S, E); } }
            } else if (sp == 10) { if (EN(9)) {
                pg8::Gemm g{U, wl + W_GU, M, NGU, D}; pg8::StaticOrder S; S.init(M, NGU, G, bx);
                pg8::EpiSwiglu E{(bf16_t*)(Pr + P_ACT)};
                for (int rep = 0; rep < REPS(9); ++rep) pg8::gemm_phase<pg8::EpiSwiglu, pg8::StaticOrder, true, true>(lds, g, S, E); }
            } else { if (EN(6)) {
                pg8::Gemm g{(const bf16_t*)(Pr + P_ACT), wl + W_DN, M, D, DFF}; pg8::StaticOrder S; S.init(M, D, G, bx);
                for (int rep = 0; rep < REPS(6); ++rep) { pg8::EpiResid E{hbuf, rep + 1 < REPS(6) ? (float*)(Pr + P_SGA) : hbuf};
                pg8::gemm_phase<pg8::EpiResid, pg8::StaticOrder, true, true>(lds, g, S, E); } }
            }
        }
        if (ph + 1 < args.ph_hi) { xcd_barrier(xbar); if (REPS(10) > 1) xcd_barrier(xbar); }
    }
}

#ifndef MK_ONE_LAUNCH
#define MK_ONE_LAUNCH 1
#endif
extern "C" void kernel_launch(void* const* d_in, const int* in_sizes, int n_in, void* d_out, int out_size, void* d_ws, size_t ws_size, hipStream_t stream) {
    static int grid = 0;
    if (grid == 0) {
        if (n_in != 21 || out_size != M * D || ws_size < WS_END) { fprintf(stderr, "kernel_launch: unexpected shapes (n_in %d, out %d, ws %zu)\n", n_in, out_size, ws_size); grid = -1; return; }
        if (hipFuncSetAttribute((const void*)fwd_kernel, hipFuncAttributeMaxDynamicSharedMemorySize, LDS_BYTES) != hipSuccess) { fprintf(stderr, "kernel_launch: hipFuncSetAttribute failed\n"); grid = -1; return; }
        int dev = 0, cus = 0, per_cu = 0;
        hipGetDevice(&dev); hipDeviceGetAttribute(&cus, hipDeviceAttributeMultiprocessorCount, dev);
        hipOccupancyMaxActiveBlocksPerMultiprocessor(&per_cu, (const void*)fwd_kernel, 512, LDS_BYTES);
        (void)hipGetLastError();
        if (per_cu < 1) per_cu = 1;
        grid = cus;
        if (grid > 256) grid = 256;
    }
    if (grid < 0) return;
    if (hipMemsetAsync(d_ws, 0, 65536, stream) != hipSuccess) { fprintf(stderr, "kernel_launch: memset of the barrier words failed\n"); return; }
    Args a{};
    for (int i = 0; i < 21; ++i) a.in[i] = (const float*)d_in[i];
    a.out = (float*)d_out; a.ws = (unsigned char*)d_ws;
#if MK_ONE_LAUNCH
    a.ph_lo = 0; a.ph_hi = N_PHASES;
    void* kargs[] = {&a};
    hipError_t e = hipLaunchCooperativeKernel((const void*)fwd_kernel, dim3(grid), dim3(512), kargs, LDS_BYTES, stream);
    if (e != hipSuccess) fprintf(stderr, "cooperative launch failed: %s (grid %d)\n", hipGetErrorString(e), grid);
#else
    for (int ph = 0; ph < N_PHASES; ++ph) { a.ph_lo = ph; a.ph_hi = ph + 1; hipLaunchKernelGGL(fwd_kernel, dim3(grid), dim3(512), LDS_BYTES, stream, a); }
#endif
}
```

```cpp
#include <hip/hip_runtime.h>
#include <hip/hip_cooperative_groups.h>
#include <cstdio>
#include <cstdint>
namespace cg = cooperative_groups;
namespace pg8 {
#define PG8_LAS __attribute__((address_space(3)))
typedef unsigned short bf16_t;
typedef short bf16x8 __attribute__((ext_vector_type(8)));
typedef float f32x4 __attribute__((ext_vector_type(4)));
typedef unsigned u32x4 __attribute__((ext_vector_type(4)));
constexpr int BM = 256, BK = 64, HALF = 128, HTB = HALF * BK * 2  , STAGE_BYTES = 8 * HTB, NXCD = 8, WGM = 8;

__host__ __device__ __forceinline__ int lds_byte(int r, int c) { const int st = (r >> 4) * 2 + (c >> 5), rr = r & 15, cc = c & 31, ob = rr * 64 + cc * 2; return st * 1024 + (ob ^ (((ob >> 9) & 1) << 5)); }
__host__ __device__ __forceinline__ void stage_rc(int b, int& R, int& C) { const int st = b / 1024, sb = b % 1024, swz = sb ^ (((sb >> 9) & 1) << 5); R = (st >> 1) * 16 + swz / 64; C = (st & 1) * 32 + (swz % 64) / 2; }
__host__ __device__ __forceinline__ int perm32(int rho) { const int n = rho >> 4, i = rho & 15; return 8 * (i >> 2) + 4 * n + (i & 3); }

struct Unit { int pm, pn; };
struct Gemm { const bf16_t* A; const bf16_t* Bt; int M, N, K; };

struct StaticOrder {
    int nM, nN, nwg, G, c;
    __host__ __device__ void init(int M, int N, int G_, int c_) { nM = M / BM; nN = N / BM; nwg = nM * nN; G = G_; c = c_; }
    __host__ __device__ bool next(int i, Unit& u) const {
        const long L = (long)i * G + c; if (L >= nwg) return false;
        int wgid = (int)L; { const int q = nwg / NXCD, r = nwg % NXCD, xcd = wgid % NXCD, off = wgid / NXCD; wgid = (xcd < r ? xcd * (q + 1) : r * (q + 1) + (xcd - r) * q) + off; }
        const int nig = WGM * nN, gid = wgid / nig, fm = gid * WGM, gsz = (nM - fm) < WGM ? (nM - fm) : WGM;
        u.pm = fm + ((wgid % nig) % gsz); u.pn = (wgid % nig) / gsz; return true;
    }
    __device__ __forceinline__ void a_ready(const Unit&) const {}
    __device__ __forceinline__ void done(const Unit&) const {}
};

typedef unsigned u32x2 __attribute__((ext_vector_type(2)));
__device__ __forceinline__ unsigned cvt_pk_bf16(float lo, float hi) { unsigned r; asm volatile("v_cvt_pk_bf16_f32 %0, %1, %2" : "=v"(r) : "v"(lo), "v"(hi)); return r; }
__device__ __forceinline__ float bf_lo(unsigned w) { return __uint_as_float(w << 16); }
__device__ __forceinline__ float bf_hi(unsigned w) { return __uint_as_float(w & 0xffff0000u); }
__device__ __forceinline__ u32x4 pack8(const f32x4 v0, const f32x4 v1) { u32x4 w; w.x = cvt_pk_bf16(v0[0], v0[1]); w.y = cvt_pk_bf16(v0[2], v0[3]); w.z = cvt_pk_bf16(v1[0], v1[1]); w.w = cvt_pk_bf16(v1[2], v1[3]); return w; }
__device__ __forceinline__ void unpack8(const u32x4 w, f32x4& v0, f32x4& v1) { v0 = (f32x4){bf_lo(w.x), bf_hi(w.x), bf_lo(w.y), bf_hi(w.y)}; v1 = (f32x4){bf_lo(w.z), bf_hi(w.z), bf_lo(w.w), bf_hi(w.w)}; }
__device__ __forceinline__ float sigmoidf_(float x) { return __builtin_amdgcn_rcpf(1.0f + __builtin_amdgcn_exp2f(-1.4426950408889634f * x)); }

constexpr int MTOK = 16384;
constexpr float QSCALE = 0.125f * 1.4426950408889634f;
constexpr float NEPS = 1e-6f;

__device__ __forceinline__ float row_rstd(const float* ssp, int row) { const f32x4* p = (const f32x4*)(ssp + (size_t)row * 16); const f32x4 a = (p[0] + p[1]) + (p[2] + p[3]); return __builtin_amdgcn_rsqf(((a[0] + a[1]) + (a[2] + a[3])) * (1.0f / 1024.0f) + NEPS); }

struct EpiPlain {
    static constexpr bool PERM = true, AFTER_DRAIN = false;
    bf16_t* O; int ldc; const float* ssp;
    __device__ __forceinline__ void operator()(const f32x4 (&acc)[2][2][4][2], const Unit& u, int wr, int wc, int fr, int fq) const {
        const int row0 = u.pm * BM + wr * 64 + fr, col0 = u.pn * BM + wc * 32 + 8 * fq;
#pragma unroll
        for (int ai = 0; ai < 2; ++ai)
#pragma unroll
            for (int m = 0; m < 4; ++m) { const int row = row0 + ai * HALF + m * 16; bf16_t* rowp = O + (size_t)row * ldc + col0; const float rs = ssp ? row_rstd(ssp, row) : 1.0f;
#pragma unroll
                for (int bj = 0; bj < 2; ++bj) *(u32x4*)(rowp + bj * HALF) = pack8(acc[ai][bj][m][0] * rs, acc[ai][bj][m][1] * rs); }
    }
};

struct EpiIn {
    static constexpr bool PERM = true, AFTER_DRAIN = false;
    bf16_t* P; const float* qg; const float* kg; const float* ssp;
    __device__ __forceinline__ void operator()(const f32x4 (&acc)[2][2][4][2], const Unit& u, int wr, int wc, int fr, int fq) const {
        const int pn = u.pn; int mode, ldc, ct; bf16_t* base;
        if (pn < 12) { const int b = pn >> 1; base = P + (size_t)b * ((size_t)MTOK * 512); ldc = 512; ct = (pn & 1) * 256; mode = (b == 0) ? 1 : (b == 1) ? 2 : 0; }
        else { const int b = (pn - 12) >> 2; base = P + (size_t)6 * MTOK * 512 + (size_t)b * ((size_t)MTOK * 1024); ldc = 1024; ct = ((pn - 12) & 3) * 256; mode = 3; }
        const int row0 = u.pm * BM + wr * 64 + fr, dcol = ct + 64 * wc + 8 * fq;
        f32x4 gv[2][2];
        if (mode == 1 || mode == 2) { const float* g = (mode == 1) ? qg : kg; const float sc = (mode == 1) ? QSCALE : 1.0f;
#pragma unroll
            for (int bj = 0; bj < 2; ++bj)
#pragma unroll
                for (int n = 0; n < 2; ++n) gv[bj][n] = *(const f32x4*)(g + 32 * bj + 8 * fq + 4 * n) * sc; }
#pragma unroll
        for (int ai = 0; ai < 2; ++ai)
#pragma unroll
            for (int m = 0; m < 4; ++m) {
                f32x4 v[2][2]; const float rsr = row_rstd(ssp, row0 + ai * HALF + m * 16);
#pragma unroll
                for (int bj = 0; bj < 2; ++bj)
#pragma unroll
                    for (int n = 0; n < 2; ++n) v[bj][n] = acc[ai][bj][m][n] * rsr;
                if (mode == 1 || mode == 2) {
                    float ss = 0.f;
#pragma unroll
                    for (int bj = 0; bj < 2; ++bj)
#pragma unroll
                        for (int n = 0; n < 2; ++n) { const f32x4 x = v[bj][n]; ss += (x[0] * x[0] + x[1] * x[1]) + (x[2] * x[2] + x[3] * x[3]); }
                    ss += __shfl_xor(ss, 16); ss += __shfl_xor(ss, 32);
                    const float rs = __builtin_amdgcn_rsqf(ss * (1.0f / 64.0f) + NEPS);
#pragma unroll
                    for (int bj = 0; bj < 2; ++bj)
#pragma unroll
                        for (int n = 0; n < 2; ++n) v[bj][n] = v[bj][n] * rs * gv[bj][n];
                } else if (mode == 3) {
#pragma unroll
                    for (int bj = 0; bj < 2; ++bj)
#pragma unroll
                        for (int n = 0; n < 2; ++n) { f32x4 x = v[bj][n]; x[0] = sigmoidf_(x[0]); x[1] = sigmoidf_(x[1]); x[2] = sigmoidf_(x[2]); x[3] = sigmoidf_(x[3]); v[bj][n] = x; }
                }
                bf16_t* rowp = base + (size_t)(row0 + ai * HALF + m * 16) * ldc + dcol;
#pragma unroll
                for (int bj = 0; bj < 2; ++bj) *(u32x4*)(rowp + 32 * bj) = pack8(v[bj][0], v[bj][1]);
            }
    }
};

template <bool ADD> struct EpiGate {
    static constexpr bool PERM = true, AFTER_DRAIN = false;
    const bf16_t* G; bf16_t* Mg;
    __device__ __forceinline__ void operator()(const f32x4 (&acc)[2][2][4][2], const Unit& u, int wr, int wc, int fr, int fq) const {
        const int row0 = u.pm * BM + wr * 64 + fr, col0 = u.pn * BM + wc * 32 + 8 * fq;
#pragma unroll
        for (int ai = 0; ai < 2; ++ai)
#pragma unroll
            for (int m = 0; m < 4; ++m) { const size_t off = (size_t)(row0 + ai * HALF + m * 16) * 1024 + col0;
#pragma unroll
                for (int bj = 0; bj < 2; ++bj) { f32x4 g0, g1; unpack8(*(const u32x4*)(G + off + bj * HALF), g0, g1);
                    f32x4 r0 = g0 * acc[ai][bj][m][0], r1 = g1 * acc[ai][bj][m][1];
                    if (ADD) { f32x4 p0, p1; unpack8(*(const u32x4*)(Mg + off + bj * HALF), p0, p1); r0 += p0; r1 += p1; }
                    *(u32x4*)(Mg + off + bj * HALF) = pack8(r0, r1); } }
    }
};

struct EpiResid {
    static constexpr bool PERM = true, AFTER_DRAIN = false;
    const float* basef; float* outf; bf16_t* HB; float* ssp;
    __device__ __forceinline__ void operator()(const f32x4 (&acc)[2][2][4][2], const Unit& u, int wr, int wc, int fr, int fq) const {
        const int row0 = u.pm * BM + wr * 64 + fr, col0 = u.pn * BM + wc * 32 + 8 * fq;
#pragma unroll
        for (int ai = 0; ai < 2; ++ai)
#pragma unroll
            for (int m = 0; m < 4; ++m) { const int row = row0 + ai * HALF + m * 16; const size_t off = (size_t)row * 1024 + col0; float ss = 0.f;
#pragma unroll
                for (int bj = 0; bj < 2; ++bj) { f32x4 b0, b1;
                    if (basef) { b0 = *(const f32x4*)(basef + off + bj * HALF); b1 = *(const f32x4*)(basef + off + bj * HALF + 4); } else unpack8(*(const u32x4*)(HB + off + bj * HALF), b0, b1);
                    const f32x4 o0 = b0 + acc[ai][bj][m][0], o1 = b1 + acc[ai][bj][m][1];
                    if (outf) { *(f32x4*)(outf + off + bj * HALF) = o0; *(f32x4*)(outf + off + bj * HALF + 4) = o1; }
                    ss += ((o0[0] * o0[0] + o0[1] * o0[1]) + (o0[2] * o0[2] + o0[3] * o0[3])) + ((o1[0] * o1[0] + o1[1] * o1[1]) + (o1[2] * o1[2] + o1[3] * o1[3]));
                    *(u32x4*)(HB + off + bj * HALF) = pack8(o0, o1); }
                ss += __shfl_xor(ss, 16); ss += __shfl_xor(ss, 32);
                if (fq == 0) ssp[(size_t)row * 16 + u.pn * 4 + wc] = ss;
                if (m & 1) asm volatile("" ::: "memory"); }
    }
};

struct EpiSwiglu {
    static constexpr bool PERM = true, AFTER_DRAIN = false;
    bf16_t* O; const float* ssp;
    __device__ __forceinline__ void operator()(const f32x4 (&acc)[2][2][4][2], const Unit& u, int wr, int wc, int fr, int fq) const {
        const int row0 = u.pm * BM + wr * 64 + fr, col0 = u.pn * HALF + wc * 32 + 8 * fq;
#pragma unroll
        for (int ai = 0; ai < 2; ++ai)
#pragma unroll
            for (int m = 0; m < 4; ++m) { f32x4 r[2]; const float rs = row_rstd(ssp, row0 + ai * HALF + m * 16);
#pragma unroll
                for (int n = 0; n < 2; ++n) { const f32x4 g = acc[ai][0][m][n] * rs, v = acc[ai][1][m][n] * rs;
#pragma unroll
                    for (int e = 0; e < 4; ++e) r[n][e] = g[e] * sigmoidf_(g[e]) * v[e]; }
                *(u32x4*)(O + (size_t)(row0 + ai * HALF + m * 16) * 2816 + col0) = pack8(r[0], r[1]); }
    }
};

template <class Epi, class Sched, bool ALIGN_EPI = false, bool SP2 = false>
__device__ __forceinline__ void gemm_phase(PG8_LAS unsigned char* lds, const Gemm g, const Sched& S, const Epi& E) {
    int tid_ = threadIdx.x; asm volatile("" : "+v"(tid_));
    const int tid = tid_, wid = __builtin_amdgcn_readfirstlane(tid >> 6), lane = tid & 63, wr = wid >> 2, wc = wid & 3, fr = lane & 15, fq = lane >> 4;
    const int K = g.K, nt = K / BK;
    unsigned voffA[2], voffB[2];
#pragma unroll
    for (int i = 0; i < 2; ++i) { int R, C; stage_rc(tid * 16 + i * 8192, R, C); const int Rb = Epi::PERM ? ((R & ~31) + perm32(R & 31)) : R;
        voffA[i] = (unsigned)(R * K + C) * 2u; voffB[i] = (unsigned)(Rb * K + C) * 2u; }
    const size_t kstep = (size_t)(BK * 2);
    const size_t hstep = (size_t)HALF * K * 2;
    const size_t tstep = 2 * hstep;
    const unsigned ldsw = (unsigned)wid * 1024u;
    const int aoff = lds_byte(wr * 64 + fr, fq * 8), boff = lds_byte(wc * 32 + fr, fq * 8);
#define PG8_SA(b, h) (((b) * 2 + (h)) * HTB)
#define PG8_SB(b, h) ((4 + (b) * 2 + (h)) * HTB)
#define PG8_STAGE(bufoff, gbase, voff) do { _Pragma("unroll") for (int _i = 0; _i < 2; ++_i) \
        __builtin_amdgcn_global_load_lds((const unsigned*)((const char*)(gbase) + (voff)[_i]), (PG8_LAS unsigned*)(lds + (bufoff) + ldsw + _i * 8192), 16, 0, 0); } while (0)
#define PG8_LDA(dst, b, h) do { _Pragma("unroll") for (int m = 0; m < 4; ++m) _Pragma("unroll") for (int k = 0; k < 2; ++k) dst[m][k] = *(const PG8_LAS bf16x8*)(lds + PG8_SA(b, h) + aoff + m * 2048 + k * 1024); } while (0)
#define PG8_LDB(dst, b, h) do { _Pragma("unroll") for (int n = 0; n < 2; ++n) _Pragma("unroll") for (int k = 0; k < 2; ++k) dst[n][k] = *(const PG8_LAS bf16x8*)(lds + PG8_SB(b, h) + boff + n * 2048 + k * 1024); } while (0)
#define PG8_MMA(ai, bj, At, Bt) do { __builtin_amdgcn_s_setprio(1); _Pragma("unroll") for (int m = 0; m < 4; ++m) _Pragma("unroll") for (int n = 0; n < 2; ++n) _Pragma("unroll") for (int k = 0; k < 2; ++k) \
        acc[ai][bj][m][n] = __builtin_amdgcn_mfma_f32_16x16x32_bf16(Bt[n][k], At[m][k], acc[ai][bj][m][n], 0, 0, 0); __builtin_amdgcn_s_setprio(0); } while (0)
#define PG8_WAIT_V(n) asm volatile("s_waitcnt vmcnt(" #n ")" ::: "memory")
#define PG8_WAIT_L(n) asm volatile("s_waitcnt lgkmcnt(" #n ")" ::: "memory")
#define PG8_BAR __builtin_amdgcn_s_barrier()
#define PG8_SCHED __builtin_amdgcn_sched_barrier(0)
    Unit cur, nxt; int ui = 0;
    if (!S.next(0, cur)) return;
    f32x4 acc[2][2][4][2];
#pragma unroll
    for (int a = 0; a < 2; ++a)
#pragma unroll
        for (int b = 0; b < 2; ++b)
#pragma unroll
            for (int m = 0; m < 4; ++m)
#pragma unroll
                for (int n = 0; n < 2; ++n) acc[a][b][m][n] = (f32x4){0.f, 0.f, 0.f, 0.f};
    bf16x8 At[4][2], B0[2][2], B1[2][2];
    const char* cA = (const char*)g.A + (size_t)cur.pm * tstep; const char* cB = (const char*)g.Bt + (size_t)cur.pn * tstep;
    S.a_ready(cur);
    if constexpr (SP2) {
        PG8_STAGE(PG8_SB(0, 0), cB, voffB); PG8_STAGE(PG8_SB(0, 1), cB + hstep, voffB); PG8_STAGE(PG8_SA(0, 0), cA, voffA); PG8_STAGE(PG8_SA(0, 1), cA + hstep, voffA);
        if (wr == 1) PG8_BAR;
        PG8_WAIT_V(2); PG8_BAR;
        PG8_STAGE(PG8_SB(1, 0), cB + kstep, voffB); PG8_STAGE(PG8_SA(1, 0), cA + kstep, voffA); PG8_STAGE(PG8_SB(1, 1), cB + hstep + kstep, voffB);
        PG8_WAIT_V(6); PG8_BAR;
    } else {
        PG8_STAGE(PG8_SB(0, 0), cB, voffB); PG8_STAGE(PG8_SA(0, 0), cA, voffA); PG8_STAGE(PG8_SB(0, 1), cB + hstep, voffB); PG8_STAGE(PG8_SA(0, 1), cA + hstep, voffA);
        if (wr == 1) PG8_BAR;
        PG8_WAIT_V(4); PG8_BAR;
        PG8_STAGE(PG8_SB(1, 0), cB + kstep, voffB); PG8_STAGE(PG8_SA(1, 0), cA + kstep, voffA); PG8_STAGE(PG8_SB(1, 1), cB + hstep + kstep, voffB);
        PG8_WAIT_V(6); PG8_BAR;
    }
    for (;;) {
        const bool has_next = S.next(ui + 1, nxt);
        const char* nA = has_next ? (const char*)g.A + (size_t)nxt.pm * tstep : cA; const char* nB = has_next ? (const char*)g.Bt + (size_t)nxt.pn * tstep : cB;
        for (int t = 0; t < nt; t += 2) {
            const bool last = (t == nt - 2);
            const char* a1 = cA + (size_t)(t + 1) * kstep;
            const char* a2 = last ? nA : cA + (size_t)(t + 2) * kstep; const char* b2 = last ? nB : cB + (size_t)(t + 2) * kstep;
            const char* a3 = a2 + kstep; const char* b3 = b2 + kstep;
            if (last && has_next) S.a_ready(nxt);
            if constexpr (SP2) {
            PG8_LDB(B0, 0, 0); PG8_LDB(B1, 0, 1); PG8_SCHED; PG8_LDA(At, 0, 0); PG8_STAGE(PG8_SA(1, 1), a1 + hstep, voffA);
            PG8_WAIT_V(8); PG8_WAIT_L(0); PG8_BAR; PG8_MMA(0, 0, At, B0); PG8_MMA(0, 1, At, B1); PG8_BAR; PG8_SCHED;
            PG8_LDA(At, 0, 1); PG8_STAGE(PG8_SB(0, 0), b2, voffB); PG8_STAGE(PG8_SB(0, 1), b2 + hstep, voffB); PG8_STAGE(PG8_SA(0, 0), a2, voffA);
            PG8_WAIT_V(8); PG8_WAIT_L(0); PG8_BAR; PG8_MMA(1, 0, At, B0); PG8_MMA(1, 1, At, B1); PG8_BAR; PG8_SCHED;
            PG8_LDB(B0, 1, 0); PG8_LDB(B1, 1, 1); PG8_SCHED; PG8_LDA(At, 1, 0); PG8_STAGE(PG8_SA(0, 1), a2 + hstep, voffA);
            PG8_WAIT_V(8); PG8_WAIT_L(0); PG8_BAR; PG8_MMA(0, 0, At, B0); PG8_MMA(0, 1, At, B1); PG8_BAR; PG8_SCHED;
            PG8_LDA(At, 1, 1); PG8_STAGE(PG8_SB(1, 0), b3, voffB); PG8_STAGE(PG8_SB(1, 1), b3 + hstep, voffB); PG8_STAGE(PG8_SA(1, 0), a3, voffA);
            PG8_WAIT_V(8); PG8_WAIT_L(0); PG8_BAR; PG8_MMA(1, 0, At, B0); PG8_MMA(1, 1, At, B1); PG8_BAR; PG8_SCHED;
            } else {
            PG8_LDB(B0, 0, 0); PG8_SCHED; PG8_LDA(At, 0, 0); PG8_STAGE(PG8_SA(1, 1), a1 + hstep, voffA);
            PG8_WAIT_L(8); PG8_BAR; PG8_WAIT_L(0); PG8_MMA(0, 0, At, B0); PG8_BAR; PG8_SCHED;
            PG8_LDB(B1, 0, 1); PG8_STAGE(PG8_SB(0, 0), b2, voffB);
            PG8_BAR; PG8_WAIT_L(0); PG8_MMA(0, 1, At, B1); PG8_BAR;
            PG8_LDA(At, 0, 1); PG8_STAGE(PG8_SA(0, 0), a2, voffA);
            PG8_BAR; PG8_WAIT_L(0); PG8_MMA(1, 0, At, B0); PG8_BAR; PG8_SCHED;
            PG8_STAGE(PG8_SB(0, 1), b2 + hstep, voffB);
            PG8_WAIT_V(6); PG8_BAR; PG8_MMA(1, 1, At, B1); PG8_BAR;
            PG8_LDB(B0, 1, 0); PG8_SCHED; PG8_LDA(At, 1, 0); PG8_STAGE(PG8_SA(0, 1), a2 + hstep, voffA);
            PG8_WAIT_L(8); PG8_BAR; PG8_WAIT_L(0); PG8_MMA(0, 0, At, B0); PG8_BAR; PG8_SCHED;
            PG8_LDB(B1, 1, 1); PG8_STAGE(PG8_SB(1, 0), b3, voffB);
            PG8_BAR; PG8_WAIT_L(0); PG8_MMA(0, 1, At, B1); PG8_BAR;
            PG8_LDA(At, 1, 1); PG8_STAGE(PG8_SA(1, 0), a3, voffA);
            PG8_BAR; PG8_WAIT_L(0); PG8_MMA(1, 0, At, B0); PG8_BAR; PG8_SCHED;
            PG8_STAGE(PG8_SB(1, 1), b3 + hstep, voffB);
            PG8_WAIT_V(6); PG8_BAR; PG8_MMA(1, 1, At, B1); PG8_BAR;
            }
        }
        if constexpr (ALIGN_EPI) { if (wr == 0) PG8_BAR; }
        if constexpr (!Epi::AFTER_DRAIN) { E(acc, cur, wr, wc, fr, fq); S.done(cur); }
        if (!has_next) break;
#pragma unroll
        for (int a = 0; a < 2; ++a)
#pragma unroll
            for (int b = 0; b < 2; ++b)
#pragma unroll
                for (int m = 0; m < 4; ++m)
#pragma unroll
                    for (int n = 0; n < 2; ++n) acc[a][b][m][n] = (f32x4){0.f, 0.f, 0.f, 0.f};
        cur = nxt; cA = nA; cB = nB; ++ui;
        if constexpr (ALIGN_EPI) { if (wr == 1) PG8_BAR; }
    }
    PG8_WAIT_V(0);
    if constexpr (!ALIGN_EPI) { if (wr == 0) PG8_BAR; }
    PG8_BAR;
    if constexpr (Epi::AFTER_DRAIN) { E.fused(acc, cur, wr, wc, fr, fq, lds, wid, lane); S.done(cur); }
#undef PG8_SA
#undef PG8_SB
#undef PG8_STAGE
#undef PG8_LDA
#undef PG8_LDB
#undef PG8_MMA
#undef PG8_WAIT_V
#undef PG8_WAIT_L
#undef PG8_BAR
#undef PG8_SCHED
}
}

#define LAS __attribute__((address_space(3)))
using pg8::bf16_t; using pg8::bf16x8; using pg8::f32x4; using pg8::u32x4;
typedef float f32x16 __attribute__((ext_vector_type(16)));
typedef short v4i16_t __attribute__((ext_vector_type(4)));
typedef unsigned u32x2 __attribute__((ext_vector_type(2)));

constexpr int M = 16384, T = 2048, NBATCH = 8, D = 1024, DEPTH = 4, INW = 5128, NIN = 5120, DFF = 2816, NGU = 5632, MEMT = 256, MROWS = NBATCH * MEMT;
constexpr float LOG2E = 1.4426950408889634f;
constexpr float MSCALE = 0.08838834764831845f * 1.4426950408889634f;
constexpr size_t MiB = 1u << 20;
constexpr size_t WS_LOGF = 1 * MiB;
constexpr size_t WS_CUM = WS_LOGF + 512 * 1024;
constexpr size_t WS_W = 2 * MiB;
constexpr size_t W_IN = 0, W_UA = 5242880, W_UB = 5767168, W_O = 6291456, W_CQ = 7340032, W_CO = 7864320, W_GU = 8388608, W_DN = 14155776, W_LAYER = 17039360;
constexpr size_t WS_U = WS_W + 130 * MiB;
constexpr size_t WS_KVM = WS_U + 32 * MiB;
constexpr size_t WS_P = WS_KVM + 16 * MiB;
constexpr size_t WS_SSP = WS_P + 160 * MiB;
constexpr size_t WS_END = WS_SSP + 1 * MiB;
static_assert(W_LAYER * 2 * 4 == 130 * MiB, "weights");
constexpr size_t P_Q = 0, P_K = 16 * MiB, P_V = 32 * MiB, P_Z = 48 * MiB, P_GB = 64 * MiB, P_GC = 80 * MiB, P_SGA = 96 * MiB, P_SGB = 128 * MiB;
constexpr size_t P_MRG = P_K;
constexpr size_t P_QM = P_Z;
constexpr size_t P_ACT = 0;
constexpr size_t P_MEMHAT = 0;
constexpr size_t P_WCKV = 16 * MiB;
constexpr int LDS_BYTES = 147456;

__device__ __forceinline__ float wave_sum(float v) {
#pragma unroll
    for (int o = 1; o < 64; o <<= 1) v += __shfl_xor(v, o);
    return v;
}
__device__ __forceinline__ unsigned pk2(float lo, float hi) { return pg8::cvt_pk_bf16(lo, hi); }

__device__ __forceinline__ int srcmap(int map, int n) {
    if (map == 1) { const int tile = n >> 8, c = n & 255; const int o = tile * 256 + 64 * ((c >> 5) & 3) + 32 * (c >> 7) + (c & 31); return o >= 1536 ? o + 8 : o; }
    if (map == 2) { const int tile = n >> 8, c = n & 255; return c < 128 ? tile * 128 + c : DFF + tile * 128 + (c - 128); }
    return n;
}
__device__ __forceinline__ void cvt_item(const float* W, int K, int Nsrc, int nblk, bf16_t* dst, int map, const float* gain, LAS float* scr, int item, int lane) {
    const int kb = item / nblk, nb = item % nblk, k0 = 64 * kb, n0 = 64 * nb;
    const int nc = (lane & 15) * 4, kr = lane >> 4;
    const int sc = srcmap(map, n0 + nc);
    const float* src = W + (size_t)(k0 + kr) * Nsrc + sc;
    f32x4 v[16];
#pragma unroll
    for (int i = 0; i < 16; ++i) v[i] = *(const f32x4*)(src + (size_t)(4 * i) * Nsrc);
    if (gain) {
#pragma unroll
        for (int i = 0; i < 16; ++i) v[i] = v[i] * gain[k0 + kr + 4 * i];
    }
#pragma unroll
    for (int i = 0; i < 16; ++i) { LAS float* p = scr + (kr + 4 * i) * 65 + nc; p[0] = v[i][0]; p[1] = v[i][1]; p[2] = v[i][2]; p[3] = v[i][3]; }
    asm volatile("s_waitcnt lgkmcnt(0)" ::: "memory");
    const int c = lane & 7;
#pragma unroll
    for (int j = 0; j < 8; ++j) { const int n = (lane >> 3) + 8 * j; const LAS float* s = scr + (8 * c) * 65 + n;
        u32x4 o; o.x = pk2(s[0], s[65]); o.y = pk2(s[2 * 65], s[3 * 65]); o.z = pk2(s[4 * 65], s[5 * 65]); o.w = pk2(s[6 * 65], s[7 * 65]);
        *(u32x4*)(dst + (size_t)(n0 + n) * K + k0 + 8 * c) = o; }
    asm volatile("s_waitcnt lgkmcnt(0)" ::: "memory");
}
struct CvtJob { const float* W; int K, Nsrc, Ndst, map; bf16_t* dst; const float* gain; };

template <bool RAW>
__device__ __forceinline__ void norm_rows(const float* src, bf16_t* dst, float* ssp, int nrows, int gw, int NGW, int lane) {
    for (int row = gw; row < nrows; row += NGW) {
        const f32x4* xr = (const f32x4*)(src + (size_t)row * D) + lane;
        f32x4 v[4]; float ss = 0.f;
#pragma unroll
        for (int j = 0; j < 4; ++j) { v[j] = xr[64 * j]; ss += (v[j][0] * v[j][0] + v[j][1] * v[j][1]) + (v[j][2] * v[j][2] + v[j][3] * v[j][3]); }
        ss = wave_sum(ss);
        const float rstd = RAW ? 1.0f : 1.0f / sqrtf(ss * (1.0f / D) + 1e-6f);
        u32x2* o8 = (u32x2*)(dst + (size_t)row * D) + lane;
#pragma unroll
        for (int j = 0; j < 4; ++j) { v[j] = v[j] * rstd; u32x2 w; w.x = pk2(v[j][0], v[j][1]); w.y = pk2(v[j][2], v[j][3]); o8[64 * j] = w; }
        if (RAW && lane < 16) ssp[(size_t)row * 16 + lane] = (lane == 0) ? ss : 0.f;
    }
}
__device__ __forceinline__ void logf_rows(const bf16_t* HB, const float* ssp, LAS const float* wf, const float* bf, float* logf, int gw, int NGW, int lane) {
    for (int row0 = gw; row0 < M; row0 += 4 * NGW) {
        u32x4 hv[4][2]; float rsv[4];
#pragma unroll
        for (int r = 0; r < 4; ++r) { const int row = row0 + r * NGW; const int rr = row < M ? row : gw; const u32x4* hp = (const u32x4*)(HB + (size_t)rr * D + lane * 16); hv[r][0] = hp[0]; hv[r][1] = hp[1]; rsv[r] = pg8::row_rstd(ssp, rr); }
#pragma unroll
        for (int r = 0; r < 4; ++r) {
            const int row = row0 + r * NGW;
            f32x4 x[4]; pg8::unpack8(hv[r][0], x[0], x[1]); pg8::unpack8(hv[r][1], x[2], x[3]);
            float a[8];
#pragma unroll
            for (int i = 0; i < 8; ++i) a[i] = 0.f;
#pragma unroll
            for (int e = 0; e < 16; ++e) { const LAS f32x4* wp = (const LAS f32x4*)(wf + (e * 64 + lane) * 8); const f32x4 w0 = wp[0], w1 = wp[1]; const float xv = x[e >> 2][e & 3];
                a[0] += xv * w0[0]; a[1] += xv * w0[1]; a[2] += xv * w0[2]; a[3] += xv * w0[3]; a[4] += xv * w1[0]; a[5] += xv * w1[1]; a[6] += xv * w1[2]; a[7] += xv * w1[3]; }
            float b4[4], b2[2], b1;
            { const bool hi_ = (lane & 32) != 0;
#pragma unroll
              for (int i = 0; i < 4; ++i) { const float snd = hi_ ? a[i] : a[i + 4]; const float kp = hi_ ? a[i + 4] : a[i]; b4[i] = kp + __shfl_xor(snd, 32); } }
            { const bool hi_ = (lane & 16) != 0;
#pragma unroll
              for (int i = 0; i < 2; ++i) { const float snd = hi_ ? b4[i] : b4[i + 2]; const float kp = hi_ ? b4[i + 2] : b4[i]; b2[i] = kp + __shfl_xor(snd, 16); } }
            { const bool hi_ = (lane & 8) != 0; const float snd = hi_ ? b2[0] : b2[1]; const float kp = hi_ ? b2[1] : b2[0]; b1 = kp + __shfl_xor(snd, 8); }
            b1 += __shfl_xor(b1, 4); b1 += __shfl_xor(b1, 2); b1 += __shfl_xor(b1, 1);
            if ((lane & 7) == 0 && row < M) { const int hh = lane >> 3; const float xx = b1 * rsv[r] + bf[hh]; logf[(size_t)row * 8 + hh] = fminf(xx, 0.f) - log1pf(expf(-fabsf(xx))); }
        }
    }
}
constexpr int LDS_CUM = 65536;
__device__ __forceinline__ void block_cumsum(LAS unsigned char* lds, const float* logf, int b, int h, int tid, int lane, int wave) {
    LAS float* cl = (LAS float*)(lds + LDS_CUM); LAS float* wt = (LAS float*)(lds + LDS_CUM + 8192);
    __syncthreads();
    const float* src = logf + ((size_t)b * T + 4 * tid) * 8 + h;
    const float s0 = src[0], s1 = s0 + src[8], s2 = s1 + src[16], s3 = s2 + src[24];
    float inc = s3;
#pragma unroll
    for (int o = 1; o < 64; o <<= 1) { const float y = __shfl_up(inc, o); if (lane >= o) inc += y; }
    if (lane == 63) wt[wave] = inc;
    __syncthreads();
    float pre = 0.f;
#pragma unroll
    for (int w = 0; w < 8; ++w) { const float x = wt[w]; if (w < wave) pre += x; }
    const float base = pre + inc - s3;
    *(LAS f32x4*)(cl + 4 * tid) = (f32x4){(base + s0) * LOG2E, (base + s1) * LOG2E, (base + s2) * LOG2E, (base + s3) * LOG2E};
    __syncthreads();
}

__device__ __forceinline__ int crow(int r, int hi) { return (r & 3) + 8 * (r >> 2) + 4 * hi; }
template <int HD, bool FOX>
__device__ __forceinline__ void attn_unit(LAS unsigned char* lds, const bf16_t* Qb, int ldq, const bf16_t* Kb, const bf16_t* Vb, int ldk, bf16_t* Ob, int nkt, int tband, const LAS float* cp, int q0, const float* qgain, const float* kgain) {
    constexpr int KS = HD / 16, DB = HD / 32, NCH = HD / 64, KP = HD * 2 + 16, KBUF = 64 * KP, VBUF = DB * 4096;
    constexpr int OFF_K = 0, OFF_V = 2 * KBUF, OFF_CK = OFF_V + 2 * VBUF, OFF_WS = OFF_CK + 512;
    int tid_ = threadIdx.x; asm volatile("" : "+v"(tid_));
    const int tid = tid_, lane = tid & 63, wid = __builtin_amdgcn_readfirstlane(tid >> 6), r32 = lane & 31, hi = lane >> 5;
    LAS float* wsf = (LAS float*)(lds + OFF_WS) + wid * 64;
    bf16x8 qr[KS];
    { const bf16_t* qrow = Qb + (size_t)(wid * 32 + r32) * ldq + hi * 8;
#pragma unroll
      for (int ks = 0; ks < KS; ++ks) qr[ks] = *(const bf16x8*)(qrow + ks * 16);
      if (!FOX) {
          float ss = 0.f;
#pragma unroll
          for (int ks = 0; ks < KS; ++ks)
#pragma unroll
              for (int e = 0; e < 8; ++e) { const float x = __uint_as_float(((unsigned)(unsigned short)qr[ks][e]) << 16); ss += x * x; }
          ss += __shfl_xor(ss, 32);
          const float rs = MSCALE / sqrtf(ss * (1.0f / HD) + 1e-6f);
#pragma unroll
          for (int ks = 0; ks < KS; ++ks) { const f32x4 g0 = *(const f32x4*)(qgain + ks * 16 + hi * 8), g1 = *(const f32x4*)(qgain + ks * 16 + hi * 8 + 4); u32x4 w;
              float x[8];
#pragma unroll
              for (int e = 0; e < 8; ++e) x[e] = __uint_as_float(((unsigned)(unsigned short)qr[ks][e]) << 16) * rs * (e < 4 ? g0[e & 3] : g1[e & 3]);
              w.x = pk2(x[0], x[1]); w.y = pk2(x[2], x[3]); w.z = pk2(x[4], x[5]); w.w = pk2(x[6], x[7]); qr[ks] = __builtin_bit_cast(bf16x8, w); }
      } }
    const float cq = FOX ? cp[q0 + wid * 32 + r32] : 0.f;
    const int skey = tid >> 3, sch = tid & 7;
    u32x4 kreg[NCH], vreg[NCH];
    f32x4 kg0[NCH], kg1[NCH];
    if (!FOX) {
#pragma unroll
        for (int i = 0; i < NCH; ++i) { kg0[i] = *(const f32x4*)(kgain + (sch + 8 * i) * 8); kg1[i] = *(const f32x4*)(kgain + (sch + 8 * i) * 8 + 4); }
    }
#define ATT_LOAD(t) do { _Pragma("unroll") for (int i_ = 0; i_ < NCH; ++i_) { const size_t go_ = (size_t)((t) * 64 + skey) * ldk + (sch + 8 * i_) * 8; kreg[i_] = *(const u32x4*)(Kb + go_); vreg[i_] = *(const u32x4*)(Vb + go_); } } while (0)
#define ATT_STORE(buf) do { \
        if (!FOX) { float ss_ = 0.f; f32x4 a_[NCH][2]; _Pragma("unroll") for (int i_ = 0; i_ < NCH; ++i_) { pg8::unpack8(kreg[i_], a_[i_][0], a_[i_][1]); \
              _Pragma("unroll") for (int h_ = 0; h_ < 2; ++h_) ss_ += (a_[i_][h_][0] * a_[i_][h_][0] + a_[i_][h_][1] * a_[i_][h_][1]) + (a_[i_][h_][2] * a_[i_][h_][2] + a_[i_][h_][3] * a_[i_][h_][3]); } \
            ss_ += __shfl_xor(ss_, 1); ss_ += __shfl_xor(ss_, 2); ss_ += __shfl_xor(ss_, 4); const float rs_ = 1.0f / sqrtf(ss_ * (1.0f / HD) + 1e-6f); \
            _Pragma("unroll") for (int i_ = 0; i_ < NCH; ++i_) kreg[i_] = pg8::pack8(a_[i_][0] * rs_ * kg0[i_], a_[i_][1] * rs_ * kg1[i_]); } \
        _Pragma("unroll") for (int i_ = 0; i_ < NCH; ++i_) { const int c_ = sch + 8 * i_; \
            *(LAS u32x4*)(lds + OFF_K + (buf) * KBUF + skey * KP + c_ * 16) = kreg[i_]; \
            *(LAS u32x4*)(lds + OFF_V + (buf) * VBUF + (c_ >> 2) * 4096 + (skey >> 3) * 512 + (skey & 7) * 64 + (c_ & 3) * 16) = vreg[i_]; } } while (0)
    float mrun = -INFINITY, lrun = 0.f;
    f32x16 o[DB];
#pragma unroll
    for (int d = 0; d < DB; ++d)
#pragma unroll
        for (int r = 0; r < 16; ++r) o[d][r] = 0.f;
    ATT_LOAD(nkt - 1); ATT_STORE(0);
    __syncthreads();
    const int thi = tband + (wid >> 1);
    const int vlane = ((lane >> 4) & 1) * 32 + (lane & 3) * 8 + (4 * hi + ((lane & 15) >> 2)) * 64;
    for (int it = 0; it < nkt; ++it) {
        const int t = nkt - 1 - it, cur = it & 1;
        if (it + 1 < nkt) ATT_LOAD(t - 1);
        if (!FOX || t <= thi) {
            f32x16 p0, p1;
#pragma unroll
            for (int r = 0; r < 16; ++r) { p0[r] = cq; p1[r] = cq; }
            const LAS unsigned char* kb = lds + OFF_K + cur * KBUF + r32 * KP + hi * 16;
#pragma unroll
            for (int ks = 0; ks < KS; ++ks) { const bf16x8 b0 = *(const LAS bf16x8*)(kb + ks * 32), b1 = *(const LAS bf16x8*)(kb + 32 * KP + ks * 32);
                p0 = __builtin_amdgcn_mfma_f32_32x32x16_bf16(b0, qr[ks], p0, 0, 0, 0); p1 = __builtin_amdgcn_mfma_f32_32x32x16_bf16(b1, qr[ks], p1, 0, 0, 0); }
            if (FOX) {
                const LAS float* ckp = cp + t * 64 + 4 * hi;
#pragma unroll
                for (int g = 0; g < 4; ++g) { const f32x4 a = *(const LAS f32x4*)(ckp + 8 * g), b = *(const LAS f32x4*)(ckp + 32 + 8 * g);
#pragma unroll
                    for (int e = 0; e < 4; ++e) { p0[4 * g + e] -= a[e]; p1[4 * g + e] -= b[e]; } }
                if (t == thi) { const int qrel = 32 * (wid & 1) + r32;
#pragma unroll
                    for (int r = 0; r < 16; ++r) { const int kv = crow(r, hi); if (kv > qrel) p0[r] = -INFINITY; if (kv + 32 > qrel) p1[r] = -INFINITY; } }
            }
            float rm = fmaxf(p0[0], p1[0]);
#pragma unroll
            for (int r = 1; r < 16; ++r) rm = fmaxf(rm, fmaxf(p0[r], p1[r]));
            rm = fmaxf(rm, __shfl_xor(rm, 32));
            const float mn = fmaxf(mrun, rm);
            if (__any(mn > mrun)) {
                const float al = __builtin_amdgcn_exp2f(mrun - mn); lrun *= al; mrun = mn;
                if (hi == 0) wsf[r32] = al;
                asm volatile("s_waitcnt lgkmcnt(0)" ::: "memory");
#pragma unroll
                for (int g = 0; g < 4; ++g) { const f32x4 a = *(const LAS f32x4*)(wsf + 8 * g + 4 * hi);
#pragma unroll
                    for (int d = 0; d < DB; ++d)
#pragma unroll
                        for (int e = 0; e < 4; ++e) o[d][4 * g + e] *= a[e]; }
            }
            float sacc = 0.f;
#pragma unroll
            for (int r = 0; r < 16; ++r) { p0[r] = __builtin_amdgcn_exp2f(p0[r] - mrun); p1[r] = __builtin_amdgcn_exp2f(p1[r] - mrun); sacc += p0[r] + p1[r]; }
            lrun += sacc;
            bf16x8 pw[4];
#pragma unroll
            for (int j = 0; j < 2; ++j) { u32x4 w0, w1;
                w0.x = pk2(p0[8 * j + 0], p0[8 * j + 1]); w0.y = pk2(p0[8 * j + 2], p0[8 * j + 3]); w0.z = pk2(p0[8 * j + 4], p0[8 * j + 5]); w0.w = pk2(p0[8 * j + 6], p0[8 * j + 7]);
                w1.x = pk2(p1[8 * j + 0], p1[8 * j + 1]); w1.y = pk2(p1[8 * j + 2], p1[8 * j + 3]); w1.z = pk2(p1[8 * j + 4], p1[8 * j + 5]); w1.w = pk2(p1[8 * j + 6], p1[8 * j + 7]);
                pw[j] = __builtin_bit_cast(bf16x8, w0); pw[2 + j] = __builtin_bit_cast(bf16x8, w1); }
            const LAS unsigned char* vb = lds + OFF_V + cur * VBUF + vlane;
#pragma unroll
            for (int d = 0; d < DB; ++d)
#pragma unroll
                for (int j = 0; j < 4; ++j) {
                    const v4i16_t lo = __builtin_amdgcn_ds_read_tr16_b64_v4i16((LAS v4i16_t*)(vb + d * 4096 + j * 1024));
                    const v4i16_t hh = __builtin_amdgcn_ds_read_tr16_b64_v4i16((LAS v4i16_t*)(vb + d * 4096 + j * 1024 + 512));
                    const bf16x8 vf = (bf16x8){lo[0], lo[1], lo[2], lo[3], hh[0], hh[1], hh[2], hh[3]};
                    o[d] = __builtin_amdgcn_mfma_f32_32x32x16_bf16(pw[j], vf, o[d], 0, 0, 0);
                }
        }
        if (it + 1 < nkt) ATT_STORE(cur ^ 1);
        __syncthreads();
    }
#undef ATT_LOAD
#undef ATT_STORE
    lrun += __shfl_xor(lrun, 32);
    if (hi == 0) wsf[32 + r32] = lrun;
    asm volatile("s_waitcnt lgkmcnt(0)" ::: "memory");
    bf16_t* orow = Ob + (size_t)(wid * 32) * ldq + r32;
#pragma unroll
    for (int g = 0; g < 4; ++g) { const f32x4 lv = *(const LAS f32x4*)(wsf + 32 + 8 * g + 4 * hi);
#pragma unroll
        for (int e = 0; e < 4; ++e) { const float il = 1.0f / lv[e]; const int rr = crow(4 * g + e, hi);
#pragma unroll
            for (int d = 0; d < DB; ++d) orow[(size_t)rr * ldq + d * 32] = (bf16_t)(pk2(o[d][4 * g + e] * il, 0.f) & 0xffffu); } }
}

#define XB_TMO      128
#define XB_XCNT(j)  (256  + 64 * (j))
#define XB_XSUB(j)  (1280 + 64 * (j))
#define XB_XGEN(j)  (2304 + 64 * (j))
#define XB_TOP      3328
#define XB_TOPGEN   3392
#define XCD_BAR_WORDS 3456
#define XB_SPIN_CAP (1u << 18)

__device__ __forceinline__ unsigned xb_ld(unsigned* p)              { return __hip_atomic_load(p, __ATOMIC_RELAXED, __HIP_MEMORY_SCOPE_AGENT); }
__device__ __forceinline__ unsigned xb_add(unsigned* p, unsigned v) { return __hip_atomic_fetch_add(p, v, __ATOMIC_RELAXED, __HIP_MEMORY_SCOPE_AGENT); }
__device__ __forceinline__ unsigned xb_xcc_id() { return (unsigned)__builtin_amdgcn_s_getreg((3 << 11) | 20) & 0xFu; }
#define XB_SPIN(cond, bar) do { unsigned _sp = 0; while (cond) { __builtin_amdgcn_s_sleep(1); \
    if ((++_sp & 255u) == 0u) { if (xb_ld(&(bar)[XB_TMO])) break; if (_sp > XB_SPIN_CAP) { atomicAdd(&(bar)[XB_TMO], 1u); break; } } } } while (0)

struct XcdBarrier {
    unsigned* bar; unsigned x;
    volatile LAS unsigned* st;
};

__device__ __forceinline__ XcdBarrier xcd_barrier_post(unsigned* bar, volatile LAS unsigned* st) {
    XcdBarrier b; b.bar = bar; b.x = xb_xcc_id(); b.st = st;
    if (threadIdx.x == 0) (void)xb_add(&bar[XB_XCNT(b.x)], 1u);
    return b;
}
__device__ __forceinline__ void xcd_barrier_complete(unsigned* bar, unsigned x, unsigned& nloc, unsigned& nx) {
    const unsigned G = gridDim.x * gridDim.y * gridDim.z;
    unsigned sum, cnt, mine, sp = 0u;
    for (;;) {
        sum = 0u; cnt = 0u; mine = 0u;
#pragma unroll
        for (unsigned j = 0; j < 16; ++j) { const unsigned c = xb_ld(&bar[XB_XCNT(j)]); sum += c; cnt += (c > 0u) ? 1u : 0u; mine = (j == x) ? c : mine; }
        if (sum == G) break;
        __builtin_amdgcn_s_sleep(1);
        if ((++sp & 255u) == 0u) { if (xb_ld(&bar[XB_TMO])) break; if (sp > XB_SPIN_CAP) { atomicAdd(&bar[XB_TMO], 1u); break; } }
    }
    nloc = mine > 0u ? mine : 1u; nx = cnt > 0u ? cnt : 1u;
}

__device__ __forceinline__ void xcd_barrier(const XcdBarrier& b) {
    asm volatile("s_waitcnt vmcnt(0)" ::: "memory");
    __syncthreads();
    if (threadIdx.x == 0) {
        unsigned* bar = b.bar;
        __builtin_amdgcn_s_waitcnt(0);
        unsigned nloc = b.st[0], nx = b.st[1];
        if (nloc == 0u) { xcd_barrier_complete(bar, b.x, nloc, nx); b.st[0] = nloc; b.st[1] = nx; }
        const unsigned old = xb_add(&bar[XB_XSUB(b.x)], 1u);
        const unsigned gen = old / nloc;
        if (old + 1u == (gen + 1u) * nloc) {
            __builtin_amdgcn_fence(__ATOMIC_RELEASE, "agent");
            asm volatile("s_waitcnt vmcnt(0)" ::: "memory");
            const unsigned og = xb_add(&bar[XB_TOP], 1u);
            const unsigned tg = og / nx;
            if (og + 1u == (tg + 1u) * nx) xb_add(&bar[XB_TOPGEN], 1u);
            else XB_SPIN(xb_ld(&bar[XB_TOPGEN]) == tg, bar);
            __builtin_amdgcn_fence(__ATOMIC_ACQUIRE, "agent");
            xb_add(&bar[XB_XGEN(b.x)], 1u);
            asm volatile("s_waitcnt vmcnt(0)" ::: "memory");
        } else {
            XB_SPIN(xb_ld(&bar[XB_XGEN(b.x)]) == gen, bar);
            __builtin_amdgcn_fence(__ATOMIC_ACQUIRE, "agent");
            asm volatile("s_waitcnt vmcnt(0)" ::: "memory");
        }
    }
    __syncthreads();
}

#ifndef PH_MASK
#define PH_MASK 0xffff
#endif
#define EN(k) (((PH_MASK) >> (k)) & 1)
#ifndef REP_MASK
#define REP_MASK 0
#endif
#define REPS(k) (1 + (((REP_MASK) >> (k)) & 1))
struct Args { const float* in[21]; float* out; unsigned char* ws; int ph_lo, ph_hi; };
constexpr int N_PHASES = 2 + 9 * DEPTH;

__global__ void __launch_bounds__(512, 2) fwd_kernel(Args args) {
    extern __shared__ __attribute__((aligned(16))) unsigned char lds_raw[];
    LAS unsigned char* lds = (LAS unsigned char*)lds_raw;
    const int wave = __builtin_amdgcn_readfirstlane(threadIdx.x >> 6);
    const int G = gridDim.x, bx = blockIdx.x;
    const int vcu = (G % 8 == 0) ? (bx % 8) * (G / 8) + bx / 8 : bx;
    const int gw = vcu * 8 + wave, NGW = G * 8;
    unsigned char* ws = args.ws;
    const float* x_in = args.in[0]; const float* mem = args.in[1];
    float* hbuf = args.out;
    bf16_t* Wb = (bf16_t*)(ws + WS_W);
    bf16_t* HB = (bf16_t*)(ws + WS_U);
    bf16_t* KVM = (bf16_t*)(ws + WS_KVM);
    unsigned char* Pr = ws + WS_P;
    float* logf = (float*)(ws + WS_LOGF);
    float* ssp = (float*)(ws + WS_SSP);
    cg::grid_group grid = cg::this_grid();
    volatile LAS unsigned* bst = (volatile LAS unsigned*)(lds + (LDS_BYTES - 64));
    if (threadIdx.x < 16) ((LAS unsigned*)(lds + (LDS_BYTES - 64)))[threadIdx.x] = 0u;
    __syncthreads();
    XcdBarrier xbar = xcd_barrier_post((unsigned*)ws, bst);
    if (args.ph_hi > 100000) grid.sync();

    for (int ph = args.ph_lo; ph < args.ph_hi; ++ph) {
        int tid_ = threadIdx.x; asm volatile("" : "+v"(tid_));
        const int tid = tid_, lane = tid & 63;
        if (ph == 0) {
            LAS float* scr = (LAS float*)lds + wave * (64 * 65);
            int pre = 0;
            for (int rep = 0; rep < REPS(0); ++rep)
            for (int l = 0; l < DEPTH; ++l) {
                bf16_t* wl = Wb + (size_t)l * W_LAYER;
                for (int j = 0; j < 9; ++j) {
                    CvtJob jb;
                    switch (j) {
                    case 0: jb = CvtJob{args.in[3] + (size_t)l * D * INW, D, INW, NIN, 1, wl + W_IN, args.in[2] + (size_t)l * D}; break;
                    case 1: jb = CvtJob{args.in[8] + (size_t)l * 512 * D, 512, D, D, 0, wl + W_UA, nullptr}; break;
                    case 2: jb = CvtJob{args.in[9] + (size_t)l * 512 * D, 512, D, D, 0, wl + W_UB, nullptr}; break;
                    case 3: jb = CvtJob{args.in[10] + (size_t)l * D * D, D, D, D, 0, wl + W_O, nullptr}; break;
                    case 4: jb = CvtJob{args.in[13] + (size_t)l * D * 512, D, 512, 512, 0, wl + W_CQ, args.in[11] + (size_t)l * D}; break;
                    case 5: jb = CvtJob{args.in[14] + (size_t)l * D * 1024, D, 1024, 1024, 0, (bf16_t*)(Pr + P_WCKV) + (size_t)l * 1024 * D, args.in[12] + (size_t)l * D}; break;
                    case 6: jb = CvtJob{args.in[17] + (size_t)l * 512 * D, 512, D, D, 0, wl + W_CO, nullptr}; break;
                    case 7: jb = CvtJob{args.in[19] + (size_t)l * D * NGU, D, NGU, NGU, 2, wl + W_GU, args.in[18] + (size_t)l * D}; break;
                    default: jb = CvtJob{args.in[20] + (size_t)l * DFF * D, DFF, D, D, 0, wl + W_DN, nullptr}; break;
                    }
                    const int nblk = jb.Ndst / 64, nitems = (jb.K / 64) * nblk;
                    int start = (gw - pre % NGW + NGW) % NGW;
                    for (int it = start; it < nitems; it += NGW) cvt_item(jb.W, jb.K, jb.Nsrc, nblk, jb.dst, jb.map, jb.gain, scr, it, lane);
                    pre += nitems;
                }
            }
            norm_rows<false>(mem, (bf16_t*)(Pr + P_MEMHAT), nullptr, MROWS, gw, NGW, lane);
            norm_rows<true>(x_in, HB, ssp, M, gw, NGW, lane);
        } else if (ph == 1) {
            pg8::Gemm g{(const bf16_t*)(Pr + P_MEMHAT), (const bf16_t*)(Pr + P_WCKV), MROWS, 4096, D}; pg8::StaticOrder S; S.init(MROWS, 4096, G, bx);
            pg8::EpiPlain E{KVM, 4096, nullptr};
            for (int rep = 0; rep < REPS(1); ++rep) pg8::gemm_phase<pg8::EpiPlain, pg8::StaticOrder, true, true>(lds, g, S, E);
        } else {
            const int l = (ph - 2) / 9, sp = (ph - 2) % 9;
            const bf16_t* wl = Wb + (size_t)l * W_LAYER;
            if (sp == 0) {
                { const float* wf_src = args.in[3] + (size_t)l * D * INW + 1536; const float* gmix = args.in[2] + (size_t)l * D;
                  LAS float* wf = (LAS float*)lds;
                  for (int i = tid; i < 1024 * 8; i += 512) { const int k = i >> 3, c = i & 7; wf[((k & 15) * 64 + (k >> 4)) * 8 + c] = wf_src[(size_t)k * INW + c] * gmix[k]; }
                  __syncthreads();
                  for (int rep = 0; rep < REPS(12); ++rep) logf_rows(HB, ssp, wf, args.in[4] + l * 8, logf, gw, NGW, lane);
                  __syncthreads(); }
                pg8::Gemm g{HB, wl + W_IN, M, NIN, D}; pg8::StaticOrder S; S.init(M, NIN, G, bx);
                pg8::EpiIn E{(bf16_t*)Pr, args.in[5] + l * 64, args.in[6] + l * 64, ssp};
                for (int rep = 0; rep < REPS(3); ++rep) pg8::gemm_phase<pg8::EpiIn, pg8::StaticOrder, true, true>(lds, g, S, E);
            } else if (sp == 1) {
                bf16_t* Qb = (bf16_t*)(Pr + P_Q); const bf16_t* Kb = (const bf16_t*)(Pr + P_K); const bf16_t* Vb = (const bf16_t*)(Pr + P_V);
                for (int rep = 0; rep < REPS(4); ++rep)
                for (int v = vcu; v < 256; v += G) {
                    const int bh = v >> 2, s = v & 3, b = bh >> 3, h = bh & 7;
                    block_cumsum(lds, logf, b, h, tid, lane, wave);
                    for (int half = 0; half < 2; ++half) {
                        const int qb = half ? 7 - s : s;
                        const size_t rb = (size_t)b * T;
                        attn_unit<64, true>(lds, Qb + (rb + qb * 256) * 512 + h * 64, 512, Kb + rb * 512 + h * 64, Vb + rb * 512 + h * 64, 512, (rep + 1 < REPS(4) ? HB : Qb) + (rb + qb * 256) * 512 + h * 64,
                                            4 * (qb + 1), 4 * qb, (const LAS float*)(lds + LDS_CUM), qb * 256, nullptr, nullptr);
                    }
                }
                {
                    const bf16_t* Zb = (const bf16_t*)(Pr + P_Z); bf16_t* GBb = (bf16_t*)(Pr + P_GB); const bf16_t* GCb = (const bf16_t*)(Pr + P_GC);
                    const float* cw = args.in[7] + (size_t)l * 3 * 512 + lane * 8;
                    f32x4 w0a = *(const f32x4*)(cw), w0b = *(const f32x4*)(cw + 4), w1a = *(const f32x4*)(cw + 512), w1b = *(const f32x4*)(cw + 516), w2a = *(const f32x4*)(cw + 1024), w2b = *(const f32x4*)(cw + 1028);
                    for (int rep = 0; rep < REPS(11); ++rep)
                    for (int item = gw; item < M / 4; item += NGW) {
                        const int r0 = item * 4; const size_t eo = (size_t)r0 * 512 + lane * 8;
                        const bool head = (r0 & (T - 1)) == 0;
                        u32x4 zr[6], cr[6], gr[4];
#pragma unroll
                        for (int i = 0; i < 6; ++i) { const size_t o = (head && i < 2) ? eo : eo + (size_t)(i - 2) * 512; zr[i] = *(const u32x4*)(Zb + o); cr[i] = *(const u32x4*)(GCb + o); }
#pragma unroll
                        for (int i = 0; i < 4; ++i) gr[i] = *(const u32x4*)(GBb + eo + i * 512);
                        f32x4 xa[6], xb[6];
#pragma unroll
                        for (int i = 0; i < 6; ++i) { f32x4 za, zb, ca, cb; pg8::unpack8(zr[i], za, zb); pg8::unpack8(cr[i], ca, cb); xa[i] = za * ca; xb[i] = zb * cb;
                            if (head && i < 2) { xa[i] = (f32x4){0.f, 0.f, 0.f, 0.f}; xb[i] = xa[i]; } }
#pragma unroll
                        for (int i = 0; i < 4; ++i) { f32x4 ga, gb2; pg8::unpack8(gr[i], ga, gb2);
                            const f32x4 ya = ga * (w0a * xa[i] + w1a * xa[i + 1] + w2a * xa[i + 2]), yb = gb2 * (w0b * xb[i] + w1b * xb[i + 1] + w2b * xb[i + 2]);
                            *(u32x4*)((rep + 1 < REPS(11) ? HB : GBb) + eo + i * 512) = pg8::pack8(ya, yb); }
                    }
                }
            } else if (sp == 2) {
                for (int rep = 0; rep < REPS(5); ++rep) {
                pg8::StaticOrder S; S.init(M, D, G, bx);
                { pg8::Gemm g{(const bf16_t*)(Pr + P_Q), wl + W_UA, M, D, 512}; pg8::EpiGate<false> E{(const bf16_t*)(Pr + P_SGA), (bf16_t*)(Pr + P_MRG)};
                  pg8::gemm_phase<pg8::EpiGate<false>, pg8::StaticOrder, true, true>(lds, g, S, E); }
                { pg8::Gemm g{(const bf16_t*)(Pr + P_GB), wl + W_UB, M, D, 512}; pg8::EpiGate<true> E{(const bf16_t*)(Pr + P_SGB), (bf16_t*)(Pr + P_MRG)};
                  pg8::gemm_phase<pg8::EpiGate<true>, pg8::StaticOrder, true, true>(lds, g, S, E); } }
            } else if (sp == 3 || sp == 6 || sp == 8) {
                const bf16_t* A = (const bf16_t*)(Pr + (sp == 3 ? P_MRG : sp == 6 ? P_QM : P_ACT));
                const bf16_t* Bt = wl + (sp == 3 ? W_O : sp == 6 ? W_CO : W_DN);
                const int K = (sp == 3) ? D : (sp == 6) ? 512 : DFF;
                const float* basef = (l == 0 && sp == 3) ? x_in : nullptr;
                float* outf = (l == DEPTH - 1 && sp == 8) ? hbuf : nullptr;
                pg8::Gemm g{A, Bt, M, D, K}; pg8::StaticOrder S; S.init(M, D, G, bx);
                { pg8::EpiResid E{basef, outf, HB, ssp};
                pg8::gemm_phase<pg8::EpiResid, pg8::StaticOrder, true, true>(lds, g, S, E); }
            } else if (sp == 4) {
                pg8::Gemm g{HB, wl + W_CQ, M, 512, D}; pg8::StaticOrder S; S.init(M, 512, G, bx);
                pg8::EpiPlain E{(bf16_t*)(Pr + P_QM), 512, ssp};
                for (int rep = 0; rep < REPS(7); ++rep) pg8::gemm_phase<pg8::EpiPlain, pg8::StaticOrder, true, true>(lds, g, S, E);
            } else if (sp == 5) {
                bf16_t* Qm = (bf16_t*)(Pr + P_QM);
                for (int rep = 0; rep < REPS(8); ++rep)
                for (int v = vcu; v < 256; v += G) {
                    const int b = v >> 5, h = (v >> 3) & 3, qb = v & 7;
                    const bf16_t* Kb = KVM + (size_t)b * MEMT * 4096 + l * 1024 + h * 128;
                    bf16_t* qp = Qm + ((size_t)b * T + qb * 256) * 512 + h * 128;
                    attn_unit<128, false>(lds, qp, 512, Kb, Kb + 512, 4096, (rep + 1 < REPS(8)) ? (bf16_t*)(Pr + P_SGA) + (qp - Qm) : qp, 4, 0, (const LAS float*)nullptr, 0, args.in[15] + l * 128, args.in[16] + l * 128);
                }
            } else {
                pg8::Gemm g{HB, wl + W_GU, M, NGU, D}; pg8::StaticOrder S; S.init(M, NGU, G, bx);
                pg8::EpiSwiglu E{(bf16_t*)(Pr + P_ACT), ssp};
                for (int rep = 0; rep < REPS(9); ++rep) pg8::gemm_phase<pg8::EpiSwiglu, pg8::StaticOrder, true, true>(lds, g, S, E);
            }
        }
        if (ph + 1 < args.ph_hi) { xcd_barrier(xbar); if (REPS(10) > 1) xcd_barrier(xbar); }
    }
}

#ifndef MK_ONE_LAUNCH
#define MK_ONE_LAUNCH 1
#endif
extern "C" void kernel_launch(void* const* d_in, const int* in_sizes, int n_in, void* d_out, int out_size, void* d_ws, size_t ws_size, hipStream_t stream) {
    static int grid = 0;
    if (grid == 0) {
        if (n_in != 21 || out_size != M * D || ws_size < WS_END) { fprintf(stderr, "kernel_launch: unexpected shapes (n_in %d, out %d, ws %zu)\n", n_in, out_size, ws_size); grid = -1; return; }
        if (hipFuncSetAttribute((const void*)fwd_kernel, hipFuncAttributeMaxDynamicSharedMemorySize, LDS_BYTES) != hipSuccess) { fprintf(stderr, "kernel_launch: hipFuncSetAttribute failed\n"); grid = -1; return; }
        int dev = 0, cus = 0, per_cu = 0;
        hipGetDevice(&dev); hipDeviceGetAttribute(&cus, hipDeviceAttributeMultiprocessorCount, dev);
        hipOccupancyMaxActiveBlocksPerMultiprocessor(&per_cu, (const void*)fwd_kernel, 512, LDS_BYTES);
        (void)hipGetLastError();
        if (per_cu < 1) per_cu = 1;
        grid = cus;
        if (grid > 256) grid = 256;
    }
    if (grid < 0) return;
    if (hipMemsetAsync(d_ws, 0, 65536, stream) != hipSuccess) { fprintf(stderr, "kernel_launch: memset of the barrier words failed\n"); return; }
    Args a{};
    for (int i = 0; i < 21; ++i) a.in[i] = (const float*)d_in[i];
    a.out = (float*)d_out; a.ws = (unsigned char*)d_ws;
#if MK_ONE_LAUNCH
    a.ph_lo = 0; a.ph_hi = N_PHASES;
    void* kargs[] = {&a};
    hipError_t e = hipLaunchCooperativeKernel((const void*)fwd_kernel, dim3(grid), dim3(512), kargs, LDS_BYTES, stream);
    if (e != hipSuccess) fprintf(stderr, "cooperative launch failed: %s (grid %d)\n", hipGetErrorString(e), grid);
#else
    for (int ph = 0; ph < N_PHASES; ++ph) { a.ph_lo = ph; a.ph_hi = ph + 1; hipLaunchKernelGGL(fwd_kernel, dim3(grid), dim3(512), LDS_BYTES, stream, a); }
#endif
}
```

```cpp
#include <hip/hip_runtime.h>
#include <hip/hip_cooperative_groups.h>
#include <cstdio>
#include <cstdint>
namespace cg = cooperative_groups;
namespace pg8 {
#define PG8_LAS __attribute__((address_space(3)))
typedef unsigned short bf16_t;
typedef short bf16x8 __attribute__((ext_vector_type(8)));
typedef float f32x4 __attribute__((ext_vector_type(4)));
typedef unsigned u32x4 __attribute__((ext_vector_type(4)));
constexpr int BM = 256, BK = 64, HALF = 128, HTB = HALF * BK * 2  , STAGE_BYTES = 8 * HTB, NXCD = 8, WGM = 8;

__host__ __device__ __forceinline__ int lds_byte(int r, int c) { const int st = (r >> 4) * 2 + (c >> 5), rr = r & 15, cc = c & 31, ob = rr * 64 + cc * 2; return st * 1024 + (ob ^ (((ob >> 9) & 1) << 5)); }
__host__ __device__ __forceinline__ void stage_rc(int b, int& R, int& C) { const int st = b / 1024, sb = b % 1024, swz = sb ^ (((sb >> 9) & 1) << 5); R = (st >> 1) * 16 + swz / 64; C = (st & 1) * 32 + (swz % 64) / 2; }
__host__ __device__ __forceinline__ int perm32(int rho) { const int n = rho >> 4, i = rho & 15; return 8 * (i >> 2) + 4 * n + (i & 3); }

struct Unit { int pm, pn; };
struct Gemm { const bf16_t* A; const bf16_t* Bt; int M, N, K; const bf16_t* A2; int lda, ksplit; };

struct StaticOrder {
    int nM, nN, nwg, G, c;
    __host__ __device__ void init(int M, int N, int G_, int c_) { nM = M / BM; nN = N / BM; nwg = nM * nN; G = G_; c = c_; }
    __host__ __device__ bool next(int i, Unit& u) const {
        const long L = (long)i * G + c; if (L >= nwg) return false;
        int wgid = (int)L; { const int q = nwg / NXCD, r = nwg % NXCD, xcd = wgid % NXCD, off = wgid / NXCD; wgid = (xcd < r ? xcd * (q + 1) : r * (q + 1) + (xcd - r) * q) + off; }
        const int nig = WGM * nN, gid = wgid / nig, fm = gid * WGM, gsz = (nM - fm) < WGM ? (nM - fm) : WGM;
        u.pm = fm + ((wgid % nig) % gsz); u.pn = (wgid % nig) / gsz; return true;
    }
    __device__ __forceinline__ void a_ready(const Unit&) const {}
    __device__ __forceinline__ void done(const Unit&) const {}
};

typedef unsigned u32x2 __attribute__((ext_vector_type(2)));
__device__ __forceinline__ float shx(float v, int lane, int m) { return __int_as_float(__builtin_amdgcn_ds_bpermute((lane ^ m) << 2, __float_as_int(v))); }
__device__ __forceinline__ float shup(float v, int lane, int d) { return __int_as_float(__builtin_amdgcn_ds_bpermute((lane - d) << 2, __float_as_int(v))); }
__device__ __forceinline__ unsigned cvt_pk_bf16(float lo, float hi) { unsigned r; asm volatile("v_cvt_pk_bf16_f32 %0, %1, %2" : "=v"(r) : "v"(lo), "v"(hi)); return r; }
__device__ __forceinline__ float bf_lo(unsigned w) { return __uint_as_float(w << 16); }
__device__ __forceinline__ float bf_hi(unsigned w) { return __uint_as_float(w & 0xffff0000u); }
__device__ __forceinline__ u32x4 pack8(const f32x4 v0, const f32x4 v1) { u32x4 w; w.x = cvt_pk_bf16(v0[0], v0[1]); w.y = cvt_pk_bf16(v0[2], v0[3]); w.z = cvt_pk_bf16(v1[0], v1[1]); w.w = cvt_pk_bf16(v1[2], v1[3]); return w; }
__device__ __forceinline__ void unpack8(const u32x4 w, f32x4& v0, f32x4& v1) { v0 = (f32x4){bf_lo(w.x), bf_hi(w.x), bf_lo(w.y), bf_hi(w.y)}; v1 = (f32x4){bf_lo(w.z), bf_hi(w.z), bf_lo(w.w), bf_hi(w.w)}; }
__device__ __forceinline__ float sigmoidf_(float x) { return __builtin_amdgcn_rcpf(1.0f + __builtin_amdgcn_exp2f(-1.4426950408889634f * x)); }

constexpr int MTOK = 16384;
constexpr float QSCALE = 0.125f * 1.4426950408889634f;
constexpr float NEPS = 1e-6f;

__device__ __forceinline__ float row_rstd(const float* ssp, int row) { const f32x4* p = (const f32x4*)(ssp + (size_t)row * 16); const f32x4 a = (p[0] + p[1]) + (p[2] + p[3]); return __builtin_amdgcn_rsqf(((a[0] + a[1]) + (a[2] + a[3])) * (1.0f / 1024.0f) + NEPS); }

struct EpiPlain {
    static constexpr bool PERM = true, AFTER_DRAIN = false, HAS_MID = false, IDEM = true;
    bf16_t* O; int ldc; const float* ssp;
    __device__ __forceinline__ void operator()(const f32x4 (&acc)[2][2][4][2], const Unit& u, int wr, int wc, int fr, int fq) const {
        const int row0 = u.pm * BM + wr * 64 + fr, col0 = u.pn * BM + wc * 32 + 8 * fq;
#pragma unroll
        for (int ai = 0; ai < 2; ++ai)
#pragma unroll
            for (int m = 0; m < 4; ++m) { const int row = row0 + ai * HALF + m * 16; bf16_t* rowp = O + (size_t)row * ldc + col0; const float rs = ssp ? row_rstd(ssp, row) : 1.0f;
#pragma unroll
                for (int bj = 0; bj < 2; ++bj) *(u32x4*)(rowp + bj * HALF) = pack8(acc[ai][bj][m][0] * rs, acc[ai][bj][m][1] * rs); }
    }
};

struct EpiIn {
    static constexpr bool PERM = true, AFTER_DRAIN = false, HAS_MID = false, IDEM = true;
    bf16_t* P512; bf16_t* P1024; const float* qg; const float* kg; const float* ssp;
    __device__ __forceinline__ void operator()(const f32x4 (&acc)[2][2][4][2], const Unit& u, int wr, int wc, int fr, int fq) const {
        const int pn = u.pn; int mode, ldc, ct; bf16_t* base;
        if (pn < 12) { const int b = pn >> 1; base = P512 + (size_t)b * (1u << 20); ldc = 512; ct = (pn & 1) * 256; mode = (b == 0) ? 1 : (b == 1) ? 2 : 0; }
        else { const int b = (pn - 12) >> 2; base = P1024 + (size_t)(6 + 2 * b) * (1u << 20); ldc = 1024; ct = ((pn - 12) & 3) * 256; mode = 3; }
        const int row0 = u.pm * BM + wr * 64 + fr, dcol = ct + 64 * wc + 8 * fq;
        f32x4 gv[2][2];
        if (mode == 1 || mode == 2) { const float* g = (mode == 1) ? qg : kg; const float sc = (mode == 1) ? QSCALE : 1.0f;
#pragma unroll
            for (int bj = 0; bj < 2; ++bj)
#pragma unroll
                for (int n = 0; n < 2; ++n) gv[bj][n] = *(const f32x4*)(g + 32 * bj + 8 * fq + 4 * n) * sc; }
#pragma unroll
        for (int ai = 0; ai < 2; ++ai)
#pragma unroll
            for (int m = 0; m < 4; ++m) {
                f32x4 v[2][2]; const float rsr = row_rstd(ssp, row0 + ai * HALF + m * 16);
#pragma unroll
                for (int bj = 0; bj < 2; ++bj)
#pragma unroll
                    for (int n = 0; n < 2; ++n) v[bj][n] = (mode == 3) ? acc[ai][bj][m][n] * (-1.4426950408889634f * rsr) : acc[ai][bj][m][n] * rsr;
                if (mode == 1 || mode == 2) {
                    float ss = 0.f;
#pragma unroll
                    for (int bj = 0; bj < 2; ++bj)
#pragma unroll
                        for (int n = 0; n < 2; ++n) { const f32x4 x = v[bj][n]; ss += (x[0] * x[0] + x[1] * x[1]) + (x[2] * x[2] + x[3] * x[3]); }
                    { const int ln_ = fr + 16 * fq; ss += shx(ss, ln_, 16); ss += shx(ss, ln_, 32); }
                    const float rs = __builtin_amdgcn_rsqf(ss * (1.0f / 64.0f) + NEPS);
#pragma unroll
                    for (int bj = 0; bj < 2; ++bj)
#pragma unroll
                        for (int n = 0; n < 2; ++n) v[bj][n] = v[bj][n] * rs * gv[bj][n];
                } else if (mode == 3) {
#pragma unroll
                    for (int bj = 0; bj < 2; ++bj)
#pragma unroll
                        for (int n = 0; n < 2; ++n) { f32x4 x = v[bj][n];
                            x[0] = __builtin_amdgcn_exp2f(x[0]); x[1] = __builtin_amdgcn_exp2f(x[1]); x[2] = __builtin_amdgcn_exp2f(x[2]); x[3] = __builtin_amdgcn_exp2f(x[3]); x = x + 1.0f;
                            x[0] = __builtin_amdgcn_rcpf(x[0]); x[1] = __builtin_amdgcn_rcpf(x[1]); x[2] = __builtin_amdgcn_rcpf(x[2]); x[3] = __builtin_amdgcn_rcpf(x[3]); v[bj][n] = x; }
                }
                bf16_t* rowp = base + (size_t)(row0 + ai * HALF + m * 16) * ldc + dcol;
#pragma unroll
                for (int bj = 0; bj < 2; ++bj) *(u32x4*)(rowp + 32 * bj) = pack8(v[bj][0], v[bj][1]);
            }
    }
};

template <bool ADD> struct EpiGate {
    static constexpr bool PERM = true, AFTER_DRAIN = false, HAS_MID = false, IDEM = !ADD;
    const bf16_t* G; bf16_t* Mg;
    __device__ __forceinline__ void operator()(const f32x4 (&acc)[2][2][4][2], const Unit& u, int wr, int wc, int fr, int fq) const {
        const int row0 = u.pm * BM + wr * 64 + fr, col0 = u.pn * BM + wc * 32 + 8 * fq;
#pragma unroll
        for (int ai = 0; ai < 2; ++ai)
#pragma unroll
            for (int m = 0; m < 4; ++m) { const size_t off = (size_t)(row0 + ai * HALF + m * 16) * 1024 + col0;
#pragma unroll
                for (int bj = 0; bj < 2; ++bj) { f32x4 g0, g1; unpack8(*(const u32x4*)(G + off + bj * HALF), g0, g1);
                    f32x4 r0 = g0 * acc[ai][bj][m][0], r1 = g1 * acc[ai][bj][m][1];
                    if (ADD) { f32x4 p0, p1; unpack8(*(const u32x4*)(Mg + off + bj * HALF), p0, p1); r0 += p0; r1 += p1; }
                    *(u32x4*)(Mg + off + bj * HALF) = pack8(r0, r1); } }
    }
};

struct EpiResid {
    static constexpr bool PERM = true, AFTER_DRAIN = false, HAS_MID = false, IDEM = false;
    const float* basef; float* outf; bf16_t* HB; float* ssp;
    __device__ __forceinline__ void operator()(const f32x4 (&acc)[2][2][4][2], const Unit& u, int wr, int wc, int fr, int fq) const {
        const int row0 = u.pm * BM + wr * 64 + fr, col0 = u.pn * BM + wc * 32 + 8 * fq;
#pragma unroll
        for (int ai = 0; ai < 2; ++ai)
#pragma unroll
            for (int m = 0; m < 4; ++m) { const int row = row0 + ai * HALF + m * 16; const size_t off = (size_t)row * 1024 + col0; float ss = 0.f;
#pragma unroll
                for (int bj = 0; bj < 2; ++bj) { f32x4 b0, b1;
                    if (basef) { b0 = *(const f32x4*)(basef + off + bj * HALF); b1 = *(const f32x4*)(basef + off + bj * HALF + 4); } else unpack8(*(const u32x4*)(HB + off + bj * HALF), b0, b1);
                    const f32x4 o0 = b0 + acc[ai][bj][m][0], o1 = b1 + acc[ai][bj][m][1];
                    if (outf) { *(f32x4*)(outf + off + bj * HALF) = o0; *(f32x4*)(outf + off + bj * HALF + 4) = o1; }
                    ss += ((o0[0] * o0[0] + o0[1] * o0[1]) + (o0[2] * o0[2] + o0[3] * o0[3])) + ((o1[0] * o1[0] + o1[1] * o1[1]) + (o1[2] * o1[2] + o1[3] * o1[3]));
                    *(u32x4*)(HB + off + bj * HALF) = pack8(o0, o1); }
                { const int ln_ = fr + 16 * fq; ss += shx(ss, ln_, 16); ss += shx(ss, ln_, 32); }
                if (fq == 0) ssp[(size_t)row * 16 + u.pn * 4 + wc] = ss;
                if (m & 1) asm volatile("" ::: "memory"); }
    }
};

struct EpiGate2 {
    static constexpr bool PERM = true, AFTER_DRAIN = false, HAS_MID = true, IDEM = true;
    const bf16_t* GA; const bf16_t* GB; bf16_t* Mg;
    __device__ __forceinline__ void mid(f32x4 (&acc)[2][2][4][2], const Unit& u, int wr, int wc, int fr, int fq) const {
        int row0 = u.pm * BM + wr * 64 + fr, col0 = u.pn * BM + wc * 32 + 8 * fq;
        asm volatile("" : "+v"(row0), "+v"(col0));
#pragma unroll
        for (int ai = 0; ai < 2; ++ai)
#pragma unroll
            for (int m = 0; m < 4; ++m) { const size_t off = (size_t)(row0 + ai * HALF + m * 16) * 1024 + col0;
#pragma unroll
                for (int bj = 0; bj < 2; ++bj) { f32x4 a0, a1, b0, b1; unpack8(*(const u32x4*)(GA + off + bj * HALF), a0, a1); unpack8(*(const u32x4*)(GB + off + bj * HALF), b0, b1);
#pragma unroll
                    for (int e = 0; e < 4; ++e) { acc[ai][bj][m][0][e] *= a0[e] * __builtin_amdgcn_rcpf(fmaxf(b0[e], 1e-20f)); acc[ai][bj][m][1][e] *= a1[e] * __builtin_amdgcn_rcpf(fmaxf(b1[e], 1e-20f)); }
                    asm volatile("" ::: "memory"); } }
    }
    __device__ __forceinline__ void operator()(const f32x4 (&acc)[2][2][4][2], const Unit& u, int wr, int wc, int fr, int fq) const {
        int row0 = u.pm * BM + wr * 64 + fr, col0 = u.pn * BM + wc * 32 + 8 * fq;
        asm volatile("" : "+v"(row0), "+v"(col0));
#pragma unroll
        for (int ai = 0; ai < 2; ++ai)
#pragma unroll
            for (int m = 0; m < 4; ++m) { const size_t off = (size_t)(row0 + ai * HALF + m * 16) * 1024 + col0;
#pragma unroll
                for (int bj = 0; bj < 2; ++bj) { f32x4 b0, b1; unpack8(*(const u32x4*)(GB + off + bj * HALF), b0, b1);
#pragma unroll
                    for (int e = 0; e < 4; ++e) { b0[e] = fmaxf(b0[e], 1e-20f); b1[e] = fmaxf(b1[e], 1e-20f); }
                    *(u32x4*)(Mg + off + bj * HALF) = pack8(acc[ai][bj][m][0] * b0, acc[ai][bj][m][1] * b1); } }
    }
};

typedef float f32x2 __attribute__((ext_vector_type(2)));
struct EpiSwiglu {
    static constexpr bool PERM = true, AFTER_DRAIN = false, HAS_MID = false, IDEM = true;
    bf16_t* O; const float* ssp;
    __device__ __forceinline__ void operator()(const f32x4 (&acc)[2][2][4][2], const Unit& u, int wr, int wc, int fr, int fq) const {
        const int row0 = u.pm * BM + wr * 64 + fr, col0 = u.pn * HALF + wc * 32 + 8 * fq;
#pragma unroll
        for (int ai = 0; ai < 2; ++ai)
#pragma unroll
            for (int m = 0; m < 4; ++m) { const float rs = row_rstd(ssp, row0 + ai * HALF + m * 16); const float nrl = -1.4426950408889634f * rs, rs2 = rs * rs; u32x4 w;
#pragma unroll
                for (int n = 0; n < 2; ++n)
#pragma unroll
                    for (int h = 0; h < 2; ++h) { const f32x2 g = {acc[ai][0][m][n][2 * h], acc[ai][0][m][n][2 * h + 1]}, v = {acc[ai][1][m][n][2 * h], acc[ai][1][m][n][2 * h + 1]};
                        const f32x2 t = g * nrl; f32x2 ex; ex.x = __builtin_amdgcn_exp2f(t.x); ex.y = __builtin_amdgcn_exp2f(t.y);
                        const f32x2 d = ex + 1.0f; f32x2 r; r.x = __builtin_amdgcn_rcpf(d.x); r.y = __builtin_amdgcn_rcpf(d.y);
                        const f32x2 o = (g * v) * (r * rs2);
                        w[2 * n + h] = cvt_pk_bf16(o.x, o.y); }
                *(u32x4*)(O + (size_t)(row0 + ai * HALF + m * 16) * 2816 + col0) = w; }
    }
};

template <class Epi, class Sched, bool ALIGN_EPI = false, bool SP2 = false>
__device__ __forceinline__ void gemm_phase(PG8_LAS unsigned char* lds, const Gemm g, const Sched& S, const Epi& E) {
    int tid_ = threadIdx.x; asm volatile("" : "+v"(tid_));
    const int tid = tid_, wid = __builtin_amdgcn_readfirstlane(tid >> 6), lane = tid & 63, wr = wid >> 2, wc = wid & 3, fr = lane & 15, fq = lane >> 4;
    const int K = g.K, nt = K / BK, lda = g.lda ? g.lda : K, ksp = g.ksplit ? g.ksplit : nt + 8;
    unsigned voffA[2], voffB[2];
#pragma unroll
    for (int i = 0; i < 2; ++i) { int R, C; stage_rc(tid * 16 + i * 8192, R, C); const int Rb = Epi::PERM ? ((R & ~31) + perm32(R & 31)) : R;
        voffA[i] = (unsigned)(R * lda + C) * 2u; voffB[i] = (unsigned)(Rb * K + C) * 2u; }
    const size_t kstep = (size_t)(BK * 2);
    const size_t hstepB = (size_t)HALF * K * 2, hstepA = (size_t)HALF * lda * 2;
    const size_t tstepB = 2 * hstepB, tstepA = 2 * hstepA;
    const unsigned ldsw = (unsigned)wid * 1024u;
    const int aoff = lds_byte(wr * 64 + fr, fq * 8), boff = lds_byte(wc * 32 + fr, fq * 8);
#define PG8_SA(b, h) (((b) * 2 + (h)) * HTB)
#define PG8_SB(b, h) ((4 + (b) * 2 + (h)) * HTB)
#define PG8_STAGE(bufoff, gbase, voff) do { _Pragma("unroll") for (int _i = 0; _i < 2; ++_i) \
        __builtin_amdgcn_global_load_lds((const unsigned*)((const char*)(gbase) + (voff)[_i]), (PG8_LAS unsigned*)(lds + (bufoff) + ldsw + _i * 8192), 16, 0, 0); } while (0)
#define PG8_LDA(dst, b, h) do { _Pragma("unroll") for (int m = 0; m < 4; ++m) _Pragma("unroll") for (int k = 0; k < 2; ++k) dst[m][k] = *(const PG8_LAS bf16x8*)(lds + PG8_SA(b, h) + aoff + m * 2048 + k * 1024); } while (0)
#define PG8_LDB(dst, b, h) do { _Pragma("unroll") for (int n = 0; n < 2; ++n) _Pragma("unroll") for (int k = 0; k < 2; ++k) dst[n][k] = *(const PG8_LAS bf16x8*)(lds + PG8_SB(b, h) + boff + n * 2048 + k * 1024); } while (0)
#define PG8_MMA(ai, bj, At, Bt) do { __builtin_amdgcn_s_setprio(1); _Pragma("unroll") for (int m = 0; m < 4; ++m) _Pragma("unroll") for (int n = 0; n < 2; ++n) _Pragma("unroll") for (int k = 0; k < 2; ++k) \
        acc[ai][bj][m][n] = __builtin_amdgcn_mfma_f32_16x16x32_bf16(Bt[n][k], At[m][k], acc[ai][bj][m][n], 0, 0, 0); __builtin_amdgcn_s_setprio(0); } while (0)
#define PG8_WAIT_V(n) asm volatile("s_waitcnt vmcnt(" #n ")" ::: "memory")
#define PG8_WAIT_L(n) asm volatile("s_waitcnt lgkmcnt(" #n ")" ::: "memory")
#define PG8_BAR __builtin_amdgcn_s_barrier()
#define PG8_SCHED __builtin_amdgcn_sched_barrier(0)
    Unit cur, nxt; int ui = 0;
    if (!S.next(0, cur)) return;
    f32x4 acc[2][2][4][2];
#pragma unroll
    for (int a = 0; a < 2; ++a)
#pragma unroll
        for (int b = 0; b < 2; ++b)
#pragma unroll
            for (int m = 0; m < 4; ++m)
#pragma unroll
                for (int n = 0; n < 2; ++n) acc[a][b][m][n] = (f32x4){0.f, 0.f, 0.f, 0.f};
    bf16x8 At[4][2], B0[2][2], B1[2][2];
    const char* cA = (const char*)g.A + (size_t)cur.pm * tstepA; const char* cB = (const char*)g.Bt + (size_t)cur.pn * tstepB;
    const char* cA2 = g.A2 ? (const char*)g.A2 + (size_t)cur.pm * tstepA - (size_t)ksp * kstep : cA;
    S.a_ready(cur);
    if constexpr (SP2) {
        PG8_STAGE(PG8_SB(0, 0), cB, voffB); PG8_STAGE(PG8_SB(0, 1), cB + hstepB, voffB); PG8_STAGE(PG8_SA(0, 0), cA, voffA); PG8_STAGE(PG8_SA(0, 1), cA + hstepA, voffA);
        if (wr == 1) PG8_BAR;
        PG8_WAIT_V(2); PG8_BAR;
        PG8_STAGE(PG8_SB(1, 0), cB + kstep, voffB); PG8_STAGE(PG8_SA(1, 0), cA + kstep, voffA); PG8_STAGE(PG8_SB(1, 1), cB + hstepB + kstep, voffB);
        PG8_WAIT_V(6); PG8_BAR;
    } else {
        PG8_STAGE(PG8_SB(0, 0), cB, voffB); PG8_STAGE(PG8_SA(0, 0), cA, voffA); PG8_STAGE(PG8_SB(0, 1), cB + hstepB, voffB); PG8_STAGE(PG8_SA(0, 1), cA + hstepA, voffA);
        if (wr == 1) PG8_BAR;
        PG8_WAIT_V(4); PG8_BAR;
        PG8_STAGE(PG8_SB(1, 0), cB + kstep, voffB); PG8_STAGE(PG8_SA(1, 0), cA + kstep, voffA); PG8_STAGE(PG8_SB(1, 1), cB + hstepB + kstep, voffB);
        PG8_WAIT_V(6); PG8_BAR;
    }
    for (;;) {
        const bool has_next = S.next(ui + 1, nxt);
        const char* nA = has_next ? (const char*)g.A + (size_t)nxt.pm * tstepA : cA; const char* nB = has_next ? (const char*)g.Bt + (size_t)nxt.pn * tstepB : cB;
        const char* nA2 = (has_next && g.A2) ? (const char*)g.A2 + (size_t)nxt.pm * tstepA - (size_t)ksp * kstep : (has_next ? nA : cA2);
        for (int t = 0; t < nt; t += 2) {
            const bool last = (t == nt - 2);
            if constexpr (Epi::HAS_MID) { if (t == ksp) E.mid(acc, cur, wr, wc, fr, fq); }
            const char* a1 = (t + 1 < ksp ? cA : cA2) + (size_t)(t + 1) * kstep;
            const char* a2 = last ? nA : (t + 2 < ksp ? cA : cA2) + (size_t)(t + 2) * kstep; const char* b2 = last ? nB : cB + (size_t)(t + 2) * kstep;
            const char* a3 = a2 + kstep; const char* b3 = b2 + kstep;
            if (last && has_next) S.a_ready(nxt);
            if constexpr (SP2) {
            PG8_LDB(B0, 0, 0); PG8_LDB(B1, 0, 1); PG8_SCHED; PG8_LDA(At, 0, 0); PG8_STAGE(PG8_SA(1, 1), a1 + hstepA, voffA);
            PG8_WAIT_V(8); PG8_WAIT_L(0); PG8_BAR; PG8_MMA(0, 0, At, B0); PG8_MMA(0, 1, At, B1); PG8_BAR; PG8_SCHED;
            PG8_LDA(At, 0, 1); PG8_STAGE(PG8_SB(0, 0), b2, voffB); PG8_STAGE(PG8_SB(0, 1), b2 + hstepB, voffB); PG8_STAGE(PG8_SA(0, 0), a2, voffA);
            PG8_WAIT_V(8); PG8_WAIT_L(0); PG8_BAR; PG8_MMA(1, 0, At, B0); PG8_MMA(1, 1, At, B1); PG8_BAR; PG8_SCHED;
            PG8_LDB(B0, 1, 0); PG8_LDB(B1, 1, 1); PG8_SCHED; PG8_LDA(At, 1, 0); PG8_STAGE(PG8_SA(0, 1), a2 + hstepA, voffA);
            PG8_WAIT_V(8); PG8_WAIT_L(0); PG8_BAR; PG8_MMA(0, 0, At, B0); PG8_MMA(0, 1, At, B1); PG8_BAR; PG8_SCHED;
            PG8_LDA(At, 1, 1); PG8_STAGE(PG8_SB(1, 0), b3, voffB); PG8_STAGE(PG8_SB(1, 1), b3 + hstepB, voffB); PG8_STAGE(PG8_SA(1, 0), a3, voffA);
            PG8_WAIT_V(8); PG8_WAIT_L(0); PG8_BAR; PG8_MMA(1, 0, At, B0); PG8_MMA(1, 1, At, B1); PG8_BAR; PG8_SCHED;
            } else {
            PG8_LDB(B0, 0, 0); PG8_SCHED; PG8_LDA(At, 0, 0); PG8_STAGE(PG8_SA(1, 1), a1 + hstepA, voffA);
            PG8_WAIT_L(8); PG8_BAR; PG8_WAIT_L(0); PG8_MMA(0, 0, At, B0); PG8_BAR; PG8_SCHED;
            PG8_LDB(B1, 0, 1); PG8_STAGE(PG8_SB(0, 0), b2, voffB);
            PG8_BAR; PG8_WAIT_L(0); PG8_MMA(0, 1, At, B1); PG8_BAR;
            PG8_LDA(At, 0, 1); PG8_STAGE(PG8_SA(0, 0), a2, voffA);
            PG8_BAR; PG8_WAIT_L(0); PG8_MMA(1, 0, At, B0); PG8_BAR; PG8_SCHED;
            PG8_STAGE(PG8_SB(0, 1), b2 + hstepB, voffB);
            PG8_WAIT_V(6); PG8_BAR; PG8_MMA(1, 1, At, B1); PG8_BAR;
            PG8_LDB(B0, 1, 0); PG8_SCHED; PG8_LDA(At, 1, 0); PG8_STAGE(PG8_SA(0, 1), a2 + hstepA, voffA);
            PG8_WAIT_L(8); PG8_BAR; PG8_WAIT_L(0); PG8_MMA(0, 0, At, B0); PG8_BAR; PG8_SCHED;
            PG8_LDB(B1, 1, 1); PG8_STAGE(PG8_SB(1, 0), b3, voffB);
            PG8_BAR; PG8_WAIT_L(0); PG8_MMA(0, 1, At, B1); PG8_BAR;
            PG8_LDA(At, 1, 1); PG8_STAGE(PG8_SA(1, 0), a3, voffA);
            PG8_BAR; PG8_WAIT_L(0); PG8_MMA(1, 0, At, B0); PG8_BAR; PG8_SCHED;
            PG8_STAGE(PG8_SB(1, 1), b3 + hstepB, voffB);
            PG8_WAIT_V(6); PG8_BAR; PG8_MMA(1, 1, At, B1); PG8_BAR;
            }
        }
        if constexpr (ALIGN_EPI) { if (wr == 0) PG8_BAR; }
        if constexpr (!Epi::AFTER_DRAIN) { E(acc, cur, wr, wc, fr, fq);
#ifdef EPI_TWICE
            if constexpr (Epi::IDEM) { asm volatile("" ::: "memory"); E(acc, cur, wr, wc, fr, fq); }
#endif
            S.done(cur); }
        if (!has_next) break;
#pragma unroll
        for (int a = 0; a < 2; ++a)
#pragma unroll
            for (int b = 0; b < 2; ++b)
#pragma unroll
                for (int m = 0; m < 4; ++m)
#pragma unroll
                    for (int n = 0; n < 2; ++n) acc[a][b][m][n] = (f32x4){0.f, 0.f, 0.f, 0.f};
        cur = nxt; cA = nA; cA2 = nA2; cB = nB; ++ui;
        if constexpr (ALIGN_EPI) { if (wr == 1) PG8_BAR; }
    }
    PG8_WAIT_V(0);
    if constexpr (!ALIGN_EPI) { if (wr == 0) PG8_BAR; }
    PG8_BAR;
    if constexpr (Epi::AFTER_DRAIN) { E.fused(acc, cur, wr, wc, fr, fq, lds, wid, lane); S.done(cur); }
#undef PG8_SA
#undef PG8_SB
#undef PG8_STAGE
#undef PG8_LDA
#undef PG8_LDB
#undef PG8_MMA
#undef PG8_WAIT_V
#undef PG8_WAIT_L
#undef PG8_BAR
#undef PG8_SCHED
}
}

#define LAS __attribute__((address_space(3)))
using pg8::bf16_t; using pg8::bf16x8; using pg8::f32x4; using pg8::u32x4;
typedef float f32x16 __attribute__((ext_vector_type(16)));
typedef short v4i16_t __attribute__((ext_vector_type(4)));
typedef unsigned u32x2 __attribute__((ext_vector_type(2)));

constexpr int M = 16384, T = 2048, NBATCH = 8, D = 1024, DEPTH = 4, INW = 5128, NIN = 5120, DFF = 2816, NGU = 5632, MEMT = 256, MROWS = NBATCH * MEMT;
constexpr float LOG2E = 1.4426950408889634f;
constexpr float MSCALE = 0.08838834764831845f * 1.4426950408889634f;
constexpr size_t MiB = 1u << 20;
constexpr size_t WS_LOGF = 512 * 1024;
constexpr size_t WS_SSP = 1 * MiB;
constexpr size_t WS_W = 2 * MiB;
constexpr size_t W_IN = 0, W_UA = 5242880, W_UB = 5767168, W_O = 6291456, W_CQ = 7340032, W_CO = 7864320, W_GU = 8388608, W_DN = 14155776, W_LAYER = 17039360;
constexpr size_t WS_U = WS_W + 130 * MiB;
constexpr size_t WS_KVM = WS_U + 32 * MiB;
constexpr size_t WS_P = WS_KVM + 16 * MiB;
constexpr size_t WS_MEMHAT = WS_P + 160 * MiB;
constexpr size_t WS_WCKV = WS_MEMHAT + 4 * MiB;
constexpr size_t WS_WFIMG = 256 * 1024;
constexpr size_t WS_END = WS_WCKV + 8 * MiB;
static_assert(W_LAYER * 2 * 4 == 130 * MiB && WS_END == 369098752, "workspace map");
constexpr size_t PB_STRIDE = 20 * MiB;
constexpr size_t P_Q = 0, P_K = 2 * MiB, P_V = 4 * MiB, P_Z = 6 * MiB, P_GB = 8 * MiB, P_GC = 10 * MiB, P_SGA = 12 * MiB, P_SGB = 16 * MiB;
constexpr size_t P_MRG = P_K;
constexpr size_t P_QM = P_Z;
constexpr size_t P_ACT = 0;
constexpr int LDS_BYTES = 147456;

__device__ __forceinline__ float wave_sum(float v, int lane) {
#pragma unroll
    for (int o = 1; o < 64; o <<= 1) v += pg8::shx(v, lane, o);
    return v;
}
__device__ __forceinline__ unsigned pk2(float lo, float hi) { return pg8::cvt_pk_bf16(lo, hi); }

__device__ __forceinline__ int srcmap(int map, int n) {
    if (map == 1) { const int tile = n >> 8, c = n & 255; const int o = tile * 256 + 64 * ((c >> 5) & 3) + 32 * (c >> 7) + (c & 31); return o >= 1536 ? o + 8 : o; }
    if (map == 2) { const int tile = n >> 8, c = n & 255; return c < 128 ? tile * 128 + c : DFF + tile * 128 + (c - 128); }
    return n;
}
__device__ __forceinline__ void cvt_item(const float* W, int K, int Nsrc, int nblk, bf16_t* dst, int map, const float* gain, LAS float* scr, int item, int lane, int ldd = 0) {
    if (ldd == 0) ldd = K;
    const int kb = item / nblk, nb = item % nblk, k0 = 64 * kb, n0 = 64 * nb;
    const int nc = (lane & 15) * 4, kr = lane >> 4;
    const int sc = srcmap(map, n0 + nc);
    const float* src = W + (size_t)(k0 + kr) * Nsrc + sc;
    f32x4 v[16];
#pragma unroll
    for (int i = 0; i < 16; ++i) v[i] = *(const f32x4*)(src + (size_t)(4 * i) * Nsrc);
    if (gain) {
#pragma unroll
        for (int i = 0; i < 16; ++i) v[i] = v[i] * gain[k0 + kr + 4 * i];
    }
#pragma unroll
    for (int i = 0; i < 16; ++i) { LAS float* p = scr + (kr + 4 * i) * 65 + nc; p[0] = v[i][0]; p[1] = v[i][1]; p[2] = v[i][2]; p[3] = v[i][3]; }
    asm volatile("s_waitcnt lgkmcnt(0)" ::: "memory");
    const int c = lane & 7;
#pragma unroll
    for (int j = 0; j < 8; ++j) { const int n = (lane >> 3) + 8 * j; const LAS float* s = scr + (8 * c) * 65 + n;
        u32x4 o; o.x = pk2(s[0], s[65]); o.y = pk2(s[2 * 65], s[3 * 65]); o.z = pk2(s[4 * 65], s[5 * 65]); o.w = pk2(s[6 * 65], s[7 * 65]);
        *(u32x4*)(dst + (size_t)(n0 + n) * ldd + k0 + 8 * c) = o; }
    asm volatile("s_waitcnt lgkmcnt(0)" ::: "memory");
}
#define KARG __attribute__((address_space(4)))
typedef const char KARG* kargp_t;
#define KIN(kp_, k_) (*(const float* const KARG*)((kp_) + 8 * (k_)))
struct CvtJob { const float* W; int K, Nsrc, Ndst, map; bf16_t* dst; const float* gain; int ldd; };
__device__ __forceinline__ void cvt_layer(kargp_t kp, int l, bf16_t* wl, LAS float* scr, int gw, int NGW, int lane, int j0, int j1) {
    int pre = 0;
    for (int j = j0; j < j1; ++j) {
        CvtJob jb;
        switch (j) {
        case 0: jb = CvtJob{KIN(kp, 3) + (size_t)l * D * INW, D, INW, NIN, 1, wl + W_IN, KIN(kp, 2) + (size_t)l * D, 0}; break;
        case 1: jb = CvtJob{KIN(kp, 8) + (size_t)l * 512 * D, 512, D, D, 0, wl + W_UA, nullptr, 1024}; break;
        case 2: jb = CvtJob{KIN(kp, 9) + (size_t)l * 512 * D, 512, D, D, 0, wl + W_UA + 512, nullptr, 1024}; break;
        case 3: jb = CvtJob{KIN(kp, 10) + (size_t)l * D * D, D, D, D, 0, wl + W_O, nullptr, 0}; break;
        case 4: jb = CvtJob{KIN(kp, 13) + (size_t)l * D * 512, D, 512, 512, 0, wl + W_CQ, KIN(kp, 11) + (size_t)l * D, 0}; break;
        case 5: jb = CvtJob{KIN(kp, 17) + (size_t)l * 512 * D, 512, D, D, 0, wl + W_CO, nullptr, 0}; break;
        case 6: jb = CvtJob{KIN(kp, 19) + (size_t)l * D * NGU, D, NGU, NGU, 2, wl + W_GU, KIN(kp, 18) + (size_t)l * D, 0}; break;
        default: jb = CvtJob{KIN(kp, 20) + (size_t)l * DFF * D, DFF, D, D, 0, wl + W_DN, nullptr, 0}; break;
        }
        const int nblk = jb.Ndst / 64, nitems = (jb.K / 64) * nblk;
        const int start = (gw - pre % NGW + NGW) % NGW;
        for (int it = start; it < nitems; it += NGW) cvt_item(jb.W, jb.K, jb.Nsrc, nblk, jb.dst, jb.map, jb.gain, scr, it, lane, jb.ldd);
        pre += nitems;
    }
}

template <bool RAW>
__device__ __forceinline__ void norm_rows(const float* src, bf16_t* dst, float* ssp, int nrows, int gw, int NGW, int lane) {
    for (int row = gw; row < nrows; row += NGW) {
        const f32x4* xr = (const f32x4*)(src + (size_t)row * D) + lane;
        f32x4 v[4]; float ss = 0.f;
#pragma unroll
        for (int j = 0; j < 4; ++j) { v[j] = xr[64 * j]; ss += (v[j][0] * v[j][0] + v[j][1] * v[j][1]) + (v[j][2] * v[j][2] + v[j][3] * v[j][3]); }
        ss = wave_sum(ss, lane);
        const float rstd = RAW ? 1.0f : 1.0f / sqrtf(ss * (1.0f / D) + 1e-6f);
        u32x2* o8 = (u32x2*)(dst + (size_t)row * D) + lane;
#pragma unroll
        for (int j = 0; j < 4; ++j) { v[j] = v[j] * rstd; u32x2 w; w.x = pk2(v[j][0], v[j][1]); w.y = pk2(v[j][2], v[j][3]); o8[64 * j] = w; }
        if (RAW && lane < 16) ssp[(size_t)row * 16 + lane] = (lane == 0) ? ss : 0.f;
    }
}
__device__ __forceinline__ void logf_rows(const bf16_t* HB, const float* ssp, LAS const float* wf, const float* bf, float* logf, int gw, int NGW, int lane) {
    const int rbase = (NGW == 2048) ? (gw >> 8) * 2048 + (gw & 255) : gw, rstep = (NGW == 2048) ? 256 : NGW, rend = (NGW == 2048) ? (gw >> 8) * 2048 + 2048 : M;
    for (int row0 = rbase; row0 < rend; row0 += 4 * rstep) {
        u32x4 hv[4][2]; float rsv[4];
#pragma unroll
        for (int r = 0; r < 4; ++r) { const int row = row0 + r * rstep; const int rr = row < rend ? row : rbase; const u32x4* hp = (const u32x4*)(HB + (size_t)rr * D + lane * 16); hv[r][0] = hp[0]; hv[r][1] = hp[1]; rsv[r] = pg8::row_rstd(ssp, rr); }
#pragma unroll
        for (int r = 0; r < 4; ++r) {
            const int row = row0 + r * rstep;
            f32x4 x[4]; pg8::unpack8(hv[r][0], x[0], x[1]); pg8::unpack8(hv[r][1], x[2], x[3]);
            float a[8];
#pragma unroll
            for (int i = 0; i < 8; ++i) a[i] = 0.f;
#pragma unroll
            for (int e = 0; e < 16; ++e) { const LAS f32x4* wp = (const LAS f32x4*)(wf + (e * 64 + lane) * 8); const f32x4 w0 = wp[0], w1 = wp[1]; const float xv = x[e >> 2][e & 3];
                a[0] += xv * w0[0]; a[1] += xv * w0[1]; a[2] += xv * w0[2]; a[3] += xv * w0[3]; a[4] += xv * w1[0]; a[5] += xv * w1[1]; a[6] += xv * w1[2]; a[7] += xv * w1[3]; }
            float b4[4], b2[2], b1;
            { const bool hi_ = (lane & 32) != 0;
#pragma unroll
              for (int i = 0; i < 4; ++i) { const float snd = hi_ ? a[i] : a[i + 4]; const float kp = hi_ ? a[i + 4] : a[i]; b4[i] = kp + pg8::shx(snd, lane, 32); } }
            { const bool hi_ = (lane & 16) != 0;
#pragma unroll
              for (int i = 0; i < 2; ++i) { const float snd = hi_ ? b4[i] : b4[i + 2]; const float kp = hi_ ? b4[i + 2] : b4[i]; b2[i] = kp + pg8::shx(snd, lane, 16); } }
            { const bool hi_ = (lane & 8) != 0; const float snd = hi_ ? b2[0] : b2[1]; const float kp = hi_ ? b2[1] : b2[0]; b1 = kp + pg8::shx(snd, lane, 8); }
            b1 += pg8::shx(b1, lane, 4); b1 += pg8::shx(b1, lane, 2); b1 += pg8::shx(b1, lane, 1);
            if ((lane & 7) == 0 && row < rend) { const int hh = lane >> 3; const float xx = b1 * rsv[r] + bf[hh]; logf[(size_t)row * 8 + hh] = fminf(xx, 0.f) - log1pf(expf(-fabsf(xx))); }
        }
    }
}
constexpr int LDS_CUM = 81920;
__device__ __forceinline__ void block_cumsum(LAS unsigned char* lds, const float* logf, int b, int h, int tid, int lane, int wave) {
    LAS float* cl = (LAS float*)(lds + LDS_CUM); LAS float* wt = (LAS float*)(lds + LDS_CUM + 8192);
    __syncthreads();
    const float* src = logf + ((size_t)b * T + 4 * tid) * 8 + h;
    const float s0 = src[0], s1 = s0 + src[8], s2 = s1 + src[16], s3 = s2 + src[24];
    float inc = s3;
#pragma unroll
    for (int o = 1; o < 64; o <<= 1) { const float y = pg8::shup(inc, lane, o); if (lane >= o) inc += y; }
    if (lane == 63) wt[wave] = inc;
    __syncthreads();
    float pre = 0.f;
#pragma unroll
    for (int w = 0; w < 8; ++w) { const float x = wt[w]; if (w < wave) pre += x; }
    const float base = pre + inc - s3;
    *(LAS f32x4*)(cl + 4 * tid) = (f32x4){(base + s0) * LOG2E, (base + s1) * LOG2E, (base + s2) * LOG2E, (base + s3) * LOG2E};
    __syncthreads();
}

__device__ __forceinline__ int crow(int r, int hi) { return (r & 3) + 8 * (r >> 2) + 4 * hi; }
template <int HD, bool FOX, int TK, bool SEQ = false>
__device__ __forceinline__ void attn_unit(LAS unsigned char* lds, const bf16_t* Qb, int ldq, const bf16_t* Kb, const bf16_t* Vb, int ldk, bf16_t* Ob, int nkt, int tband, const LAS float* cp, int q0, const float* qgain, const float* kgain) {
    constexpr int KS = HD / 16, DB = HD / 32, NCH = HD / 64, KP = HD * 2 + 16, KSUB = 64 * KP, KBUF = TK * KSUB, VSUB = DB * 4096, VBUF = TK * VSUB;
    constexpr int NBUF = SEQ ? 1 : 2, OFF_K = 0, OFF_V = NBUF * KBUF, OFF_WS = OFF_V + NBUF * VBUF;
    static_assert(OFF_WS + 2048 <= (FOX ? 81920 : 147392), "attention LDS map");
    int tid_ = threadIdx.x; asm volatile("" : "+v"(tid_));
    const int tid = tid_, lane = tid & 63, wid = __builtin_amdgcn_readfirstlane(tid >> 6), r32 = lane & 31, hi = lane >> 5;
    LAS float* wsf = (LAS float*)(lds + OFF_WS) + wid * 64;
    const float cq = FOX ? cp[q0 + wid * 32 + r32] : 0.f;
    const int skey = tid >> 3, sch = tid & 7;
    u32x4 kreg[TK * NCH], vreg[TK * NCH];
    f32x4 kg0[NCH], kg1[NCH];
    if (!FOX) {
#pragma unroll
        for (int i = 0; i < NCH; ++i) { kg0[i] = *(const f32x4*)(kgain + (sch + 8 * i) * 8); kg1[i] = *(const f32x4*)(kgain + (sch + 8 * i) * 8 + 4); }
    }
#define ATT_LOAD(T_) do { _Pragma("unroll") for (int s_ = 0; s_ < TK; ++s_) _Pragma("unroll") for (int i_ = 0; i_ < NCH; ++i_) { const size_t go_ = (size_t)(((T_) * TK + s_) * 64 + skey) * ldk + (sch + 8 * i_) * 8; \
        kreg[s_ * NCH + i_] = *(const u32x4*)(Kb + go_); vreg[s_ * NCH + i_] = *(const u32x4*)(Vb + go_); } } while (0)
#define ATT_STORE(buf) do { _Pragma("unroll") for (int s_ = 0; s_ < TK; ++s_) { \
        if (!FOX) { float ss_ = 0.f; f32x4 a_[NCH][2]; _Pragma("unroll") for (int i_ = 0; i_ < NCH; ++i_) { pg8::unpack8(kreg[s_ * NCH + i_], a_[i_][0], a_[i_][1]); \
              _Pragma("unroll") for (int h_ = 0; h_ < 2; ++h_) ss_ += (a_[i_][h_][0] * a_[i_][h_][0] + a_[i_][h_][1] * a_[i_][h_][1]) + (a_[i_][h_][2] * a_[i_][h_][2] + a_[i_][h_][3] * a_[i_][h_][3]); } \
            ss_ += pg8::shx(ss_, lane, 1); ss_ += pg8::shx(ss_, lane, 2); ss_ += pg8::shx(ss_, lane, 4); const float rs_ = 1.0f / sqrtf(ss_ * (1.0f / HD) + 1e-6f); \
            _Pragma("unroll") for (int i_ = 0; i_ < NCH; ++i_) kreg[s_ * NCH + i_] = pg8::pack8(a_[i_][0] * rs_ * kg0[i_], a_[i_][1] * rs_ * kg1[i_]); } \
        _Pragma("unroll") for (int i_ = 0; i_ < NCH; ++i_) { const int c_ = sch + 8 * i_; \
            *(LAS u32x4*)(lds + OFF_K + (buf) * KBUF + s_ * KSUB + skey * KP + c_ * 16) = kreg[s_ * NCH + i_]; \
            *(LAS u32x4*)(lds + OFF_V + (buf) * VBUF + s_ * VSUB + (c_ >> 2) * 4096 + (skey >> 3) * 512 + (skey & 7) * 64 + (c_ & 3) * 16) = vreg[s_ * NCH + i_]; } } } while (0)
    float mrun = 0.f, lrun = 0.f;
    f32x16 o[DB];
#pragma unroll
    for (int d = 0; d < DB; ++d)
#pragma unroll
        for (int r = 0; r < 16; ++r) o[d][r] = 0.f;
    const int nst = nkt / TK;
    ATT_LOAD(nst - 1);
    bf16x8 qr[KS];
    { const bf16_t* qrow = Qb + (size_t)(wid * 32 + r32) * ldq + hi * 8;
#pragma unroll
      for (int ks = 0; ks < KS; ++ks) qr[ks] = *(const bf16x8*)(qrow + ks * 16);
      if (!FOX) {
          float ss = 0.f;
#pragma unroll
          for (int ks = 0; ks < KS; ++ks)
#pragma unroll
              for (int e = 0; e < 8; ++e) { const float x = __uint_as_float(((unsigned)(unsigned short)qr[ks][e]) << 16); ss += x * x; }
          ss += pg8::shx(ss, lane, 32);
          const float rs = MSCALE / sqrtf(ss * (1.0f / HD) + 1e-6f);
#pragma unroll
          for (int ks = 0; ks < KS; ++ks) { const f32x4 g0 = *(const f32x4*)(qgain + ks * 16 + hi * 8), g1 = *(const f32x4*)(qgain + ks * 16 + hi * 8 + 4); u32x4 w;
              float x[8];
#pragma unroll
              for (int e = 0; e < 8; ++e) x[e] = __uint_as_float(((unsigned)(unsigned short)qr[ks][e]) << 16) * rs * (e < 4 ? g0[e & 3] : g1[e & 3]);
              w.x = pk2(x[0], x[1]); w.y = pk2(x[2], x[3]); w.z = pk2(x[4], x[5]); w.w = pk2(x[6], x[7]); qr[ks] = __builtin_bit_cast(bf16x8, w); }
      } }
    ATT_STORE(0);
    __syncthreads();
    const int dsub = tband + (wid >> 1);
    const int vlane = ((lane >> 4) & 1) * 32 + (lane & 3) * 8 + (4 * hi + ((lane & 15) >> 2)) * 64;
    for (int it = 0; it < nst; ++it) {
        const int T_ = nst - 1 - it, cur = it & 1, jlo = T_ * TK;
        if (!SEQ && it + 1 < nst) ATT_LOAD(T_ - 1);
        const bool active = !FOX || jlo <= dsub;
        f32x16 pA0, pA1, pB0, pB1;
        bool first = false; bool actB = false;
        for (int sq = 0; sq < (SEQ ? TK : 1); ++sq) {
        if (active) {
            first = FOX ? (dsub < jlo + TK) : (it == 0 && sq == 0);
            const float base = first ? cq : cq - mrun;
#define ATT_QK(S, P0, P1) do { \
                if (!FOX || jlo + (S) <= dsub) { \
                    if (FOX) { const LAS float* ckp = cp + (jlo + (S)) * 64 + 4 * hi; \
                        _Pragma("unroll") for (int g = 0; g < 4; ++g) { const f32x4 a = *(const LAS f32x4*)(ckp + 8 * g), b = *(const LAS f32x4*)(ckp + 32 + 8 * g); \
                            _Pragma("unroll") for (int e = 0; e < 4; ++e) { P0[4 * g + e] = base - a[e]; P1[4 * g + e] = base - b[e]; } } \
                    } else { _Pragma("unroll") for (int r = 0; r < 16; ++r) { P0[r] = base; P1[r] = base; } } \
                    const LAS unsigned char* kb = lds + OFF_K + cur * KBUF + (S) * KSUB + r32 * KP + hi * 16; \
                    _Pragma("unroll") for (int ks = 0; ks < KS; ++ks) { const bf16x8 b0 = *(const LAS bf16x8*)(kb + ks * 32), b1 = *(const LAS bf16x8*)(kb + 32 * KP + ks * 32); \
                        P0 = __builtin_amdgcn_mfma_f32_32x32x16_bf16(b0, qr[ks], P0, 0, 0, 0); P1 = __builtin_amdgcn_mfma_f32_32x32x16_bf16(b1, qr[ks], P1, 0, 0, 0); } \
                    if (FOX && jlo + (S) == dsub) { const int qrel = 32 * (wid & 1) + r32; \
                        _Pragma("unroll") for (int r = 0; r < 16; ++r) { const int kv = crow(r, hi); if (kv > qrel) P0[r] = -INFINITY; if (kv + 32 > qrel) P1[r] = -INFINITY; } } \
                } } while (0)
            actB = !SEQ && (TK > 1) && (!FOX || jlo + 1 <= dsub);
            ATT_QK(sq, pA0, pA1);
            if (!SEQ && TK > 1) { __builtin_amdgcn_sched_barrier(0); ATT_QK(1, pB0, pB1); }
        }
        if (active) {
            float rm = fmaxf(pA0[0], pA1[0]);
#pragma unroll
            for (int r = 1; r < 16; ++r) rm = fmaxf(fmaxf(rm, pA0[r]), pA1[r]);
            if (actB) {
#pragma unroll
                for (int r = 0; r < 16; ++r) rm = fmaxf(fmaxf(rm, pB0[r]), pB1[r]);
            }
            rm = fmaxf(rm, pg8::shx(rm, lane, 32));
            if (first) {
                mrun = rm;
#pragma unroll
                for (int r = 0; r < 16; ++r) { pA0[r] -= rm; pA1[r] -= rm; }
                if (actB) {
#pragma unroll
                    for (int r = 0; r < 16; ++r) { pB0[r] -= rm; pB1[r] -= rm; } }
            } else if (__any(rm > 0.f)) {
                const float dl = fmaxf(rm, 0.f); const float al = __builtin_amdgcn_exp2f(-dl); lrun *= al; mrun += dl;
#pragma unroll
                for (int r = 0; r < 16; ++r) { pA0[r] -= dl; pA1[r] -= dl; }
                if (actB) {
#pragma unroll
                    for (int r = 0; r < 16; ++r) { pB0[r] -= dl; pB1[r] -= dl; } }
                if (hi == 0) wsf[r32] = al;
                asm volatile("s_waitcnt lgkmcnt(0)" ::: "memory");
#pragma unroll
                for (int g = 0; g < 4; ++g) { const f32x4 a = *(const LAS f32x4*)(wsf + 8 * g + 4 * hi);
#pragma unroll
                    for (int d = 0; d < DB; ++d)
#pragma unroll
                        for (int e = 0; e < 4; ++e) o[d][4 * g + e] *= a[e]; }
            }
#define ATT_PV(S, P0, P1) do { \
                if (!FOX || jlo + (S) <= dsub) { \
                    float sacc = 0.f; \
                    _Pragma("unroll") for (int r = 0; r < 16; ++r) { P0[r] = __builtin_amdgcn_exp2f(P0[r]); P1[r] = __builtin_amdgcn_exp2f(P1[r]); sacc += P0[r] + P1[r]; } \
                    lrun += sacc; \
                    bf16x8 pw[4]; \
                    _Pragma("unroll") for (int j = 0; j < 2; ++j) { u32x4 w0, w1; \
                        w0.x = pk2(P0[8 * j + 0], P0[8 * j + 1]); w0.y = pk2(P0[8 * j + 2], P0[8 * j + 3]); w0.z = pk2(P0[8 * j + 4], P0[8 * j + 5]); w0.w = pk2(P0[8 * j + 6], P0[8 * j + 7]); \
                        w1.x = pk2(P1[8 * j + 0], P1[8 * j + 1]); w1.y = pk2(P1[8 * j + 2], P1[8 * j + 3]); w1.z = pk2(P1[8 * j + 4], P1[8 * j + 5]); w1.w = pk2(P1[8 * j + 6], P1[8 * j + 7]); \
                        pw[j] = __builtin_bit_cast(bf16x8, w0); pw[2 + j] = __builtin_bit_cast(bf16x8, w1); } \
                    const LAS unsigned char* vb = lds + OFF_V + cur * VBUF + (S) * VSUB + vlane; \
                    _Pragma("unroll") for (int d = 0; d < DB; ++d) \
                        _Pragma("unroll") for (int j = 0; j < 4; ++j) { \
                            const v4i16_t lo = __builtin_amdgcn_ds_read_tr16_b64_v4i16((LAS v4i16_t*)(vb + d * 4096 + j * 1024)); \
                            const v4i16_t hh = __builtin_amdgcn_ds_read_tr16_b64_v4i16((LAS v4i16_t*)(vb + d * 4096 + j * 1024 + 512)); \
                            const bf16x8 vf = (bf16x8){lo[0], lo[1], lo[2], lo[3], hh[0], hh[1], hh[2], hh[3]}; \
                            o[d] = __builtin_amdgcn_mfma_f32_32x32x16_bf16(pw[j], vf, o[d], 0, 0, 0); } \
                } } while (0)
            ATT_PV(sq, pA0, pA1);
            if (!SEQ && TK > 1) { __builtin_amdgcn_sched_barrier(0); ATT_PV(1, pB0, pB1); }
#undef ATT_QK
#undef ATT_PV
        }
        }
        if (!SEQ && it + 1 < nst) ATT_STORE(cur ^ 1);
        __syncthreads();
    }
#undef ATT_LOAD
#undef ATT_STORE
    lrun += pg8::shx(lrun, lane, 32);
    if (hi == 0) wsf[32 + r32] = lrun;
    asm volatile("s_waitcnt lgkmcnt(0)" ::: "memory");
    LAS bf16_t* stg = (LAS bf16_t*)(lds + (SEQ ? 0 : OFF_WS + 2048) + wid * (32 * (HD + 8) * 2));
    static_assert((SEQ ? 0 : OFF_WS + 2048) + 8 * 32 * (HD + 8) * 2 <= (SEQ ? KBUF : (FOX ? 81920 : 147392)), "attention LDS map (O stage)");
#pragma unroll
    for (int g = 0; g < 4; ++g) { const f32x4 lv = *(const LAS f32x4*)(wsf + 32 + 8 * g + 4 * hi);
#pragma unroll
        for (int e = 0; e < 4; ++e) { const float il = 1.0f / lv[e]; const int rr = crow(4 * g + e, hi);
#pragma unroll
            for (int d = 0; d < DB; ++d) stg[rr * (HD + 8) + d * 32 + r32] = (bf16_t)(pk2(o[d][4 * g + e] * il, 0.f) & 0xffffu); } }
    asm volatile("s_waitcnt lgkmcnt(0)" ::: "memory");
    constexpr int CPR = HD / 8;
#pragma unroll
    for (int i = 0; i < (32 * CPR) / 64; ++i) { const int idx = i * 64 + lane, row = idx / CPR, ch = idx % CPR;
        const u32x4 v = *(const LAS u32x4*)(stg + row * (HD + 8) + ch * 8);
        *(u32x4*)(Ob + (size_t)(wid * 32 + row) * ldq + ch * 8) = v; }
    if (SEQ) __syncthreads();
}

#define XB_TMO      128
#define XB_XCNT(j)  (256  + 64 * (j))
#define XB_XSUB(j)  (1280 + 64 * (j))
#define XB_XGEN(j)  (2304 + 64 * (j))
#define XB_TOP      3328
#define XB_TOPGEN   3392
#define XCD_BAR_WORDS 3456
#define XB_SPIN_CAP (1u << 18)

__device__ __forceinline__ unsigned xb_ld(unsigned* p)              { return __hip_atomic_load(p, __ATOMIC_RELAXED, __HIP_MEMORY_SCOPE_AGENT); }
__device__ __forceinline__ unsigned xb_add(unsigned* p, unsigned v) { return __hip_atomic_fetch_add(p, v, __ATOMIC_RELAXED, __HIP_MEMORY_SCOPE_AGENT); }
__device__ __forceinline__ unsigned xb_xcc_id() { return (unsigned)__builtin_amdgcn_s_getreg((3 << 11) | 20) & 0xFu; }
#define XB_SPIN(cond, bar) do { unsigned _sp = 0; while (cond) { __builtin_amdgcn_s_sleep(1); \
    if ((++_sp & 255u) == 0u) { if (xb_ld(&(bar)[XB_TMO])) break; if (_sp > XB_SPIN_CAP) { atomicAdd(&(bar)[XB_TMO], 1u); break; } } } } while (0)

struct XcdBarrier {
    unsigned* bar; unsigned x;
    volatile LAS unsigned* st;
};

__device__ __forceinline__ XcdBarrier xcd_barrier_post(unsigned* bar, volatile LAS unsigned* st) {
    XcdBarrier b; b.bar = bar; b.x = xb_xcc_id(); b.st = st;
    if (threadIdx.x == 0) (void)xb_add(&bar[XB_XCNT(b.x)], 1u);
    return b;
}
__device__ __forceinline__ void xcd_barrier_complete(unsigned* bar, unsigned x, unsigned& nloc, unsigned& nx) {
    const unsigned G = gridDim.x * gridDim.y * gridDim.z;
    unsigned sum, cnt, mine, sp = 0u;
    for (;;) {
        sum = 0u; cnt = 0u; mine = 0u;
#pragma unroll
        for (unsigned j = 0; j < 16; ++j) { const unsigned c = xb_ld(&bar[XB_XCNT(j)]); sum += c; cnt += (c > 0u) ? 1u : 0u; mine = (j == x) ? c : mine; }
        if (sum == G) break;
        __builtin_amdgcn_s_sleep(1);
        if ((++sp & 255u) == 0u) { if (xb_ld(&bar[XB_TMO])) break; if (sp > XB_SPIN_CAP) { atomicAdd(&bar[XB_TMO], 1u); break; } }
    }
    nloc = mine > 0u ? mine : 1u; nx = cnt > 0u ? cnt : 1u;
}

__device__ __forceinline__ void xcd_barrier(const XcdBarrier& b) {
    asm volatile("s_waitcnt vmcnt(0)" ::: "memory");
    __syncthreads();
    if (threadIdx.x == 0) {
        unsigned* bar = b.bar;
        __builtin_amdgcn_s_waitcnt(0);
        unsigned nloc = b.st[0], nx = b.st[1];
        if (nloc == 0u) { xcd_barrier_complete(bar, b.x, nloc, nx); b.st[0] = nloc; b.st[1] = nx; }
        const unsigned old = xb_add(&bar[XB_XSUB(b.x)], 1u);
        const unsigned gen = old / nloc;
        if (old + 1u == (gen + 1u) * nloc) {
            __builtin_amdgcn_fence(__ATOMIC_RELEASE, "agent");
            asm volatile("s_waitcnt vmcnt(0)" ::: "memory");
            const unsigned og = xb_add(&bar[XB_TOP], 1u);
            const unsigned tg = og / nx;
            if (og + 1u == (tg + 1u) * nx) xb_add(&bar[XB_TOPGEN], 1u);
            else XB_SPIN(xb_ld(&bar[XB_TOPGEN]) == tg, bar);
            __builtin_amdgcn_fence(__ATOMIC_ACQUIRE, "agent");
            xb_add(&bar[XB_XGEN(b.x)], 1u);
            asm volatile("s_waitcnt vmcnt(0)" ::: "memory");
        } else {
            XB_SPIN(xb_ld(&bar[XB_XGEN(b.x)]) == gen, bar);
            __builtin_amdgcn_fence(__ATOMIC_ACQUIRE, "agent");
            asm volatile("s_waitcnt vmcnt(0)" ::: "memory");
        }
    }
    __syncthreads();
}

#define XL_SUB(j)  (4096 + 64 * (j))
#define XL_GEN(j)  (5120 + 64 * (j))
#define XL_BAD     6400
#define XL_MAP     6464
__device__ __forceinline__ void xcd_local_barrier(const XcdBarrier& b) {
    asm volatile("s_waitcnt vmcnt(0)" ::: "memory");
    __syncthreads();
    if (threadIdx.x == 0) {
        unsigned* bar = b.bar;
        __builtin_amdgcn_s_waitcnt(0);
        const unsigned nloc = b.st[0];
        const unsigned old = xb_add(&bar[XL_SUB(b.x)], 1u);
        const unsigned gen = old / nloc;
        const unsigned target = (gen + 1u) * nloc;
        if (old + 1u != target) XB_SPIN(xb_ld(&bar[XL_SUB(b.x)]) < target, bar);
        __builtin_amdgcn_fence(__ATOMIC_ACQUIRE, "agent");
        asm volatile("s_waitcnt vmcnt(0)" ::: "memory");
    }
    __syncthreads();
}
#ifndef PH_MASK
#define PH_MASK 0xffff
#endif
#define EN(k) (((PH_MASK) >> (k)) & 1)
#ifndef REP_MASK
#define REP_MASK 0
#endif
#define REPS(k) (1 + (((REP_MASK) >> (k)) & 1))
struct Args { const float* in[21]; float* out; unsigned char* ws; int ph_lo, ph_hi; };
constexpr int N_PHASES = 1 + 9 * DEPTH;

__global__ void __launch_bounds__(512, 2) fwd_kernel(Args args) {
    extern __shared__ __attribute__((aligned(16))) unsigned char lds_raw[];
    LAS unsigned char* lds = (LAS unsigned char*)lds_raw;
    const int wave = __builtin_amdgcn_readfirstlane(threadIdx.x >> 6);
    const int G = gridDim.x, bx = blockIdx.x;
    const int vcu = (G % 8 == 0) ? (bx % 8) * (G / 8) + bx / 8 : bx;
    const int gw = vcu * 8 + wave, NGW = G * 8;
    kargp_t kp = (kargp_t)__builtin_amdgcn_kernarg_segment_ptr();
    unsigned char* ws = args.ws;
    bf16_t* Wb = (bf16_t*)(ws + WS_W);
    bf16_t* HB = (bf16_t*)(ws + WS_U);
    bf16_t* KVM = (bf16_t*)(ws + WS_KVM);
    unsigned char* Pr = ws + WS_P;
    const size_t b_own = (size_t)(bx & 7);
#define PB512(off)  ((bf16_t*)(Pr + b_own * PB_STRIDE + (off) - b_own * ((size_t)T * 512 * 2)))
#define PB1024(off) ((bf16_t*)(Pr + b_own * PB_STRIDE + (off) - b_own * ((size_t)T * 1024 * 2)))
#define PB2816(off) ((bf16_t*)(Pr + b_own * PB_STRIDE + (off) - b_own * ((size_t)T * DFF * 2)))
    float* logf = (float*)(ws + WS_LOGF);
    float* ssp = (float*)(ws + WS_SSP);
    cg::grid_group grid = cg::this_grid();
    volatile LAS unsigned* bst = (volatile LAS unsigned*)(lds + (LDS_BYTES - 64));
    if (threadIdx.x < 16) ((LAS unsigned*)(lds + (LDS_BYTES - 64)))[threadIdx.x] = 0u;
    __syncthreads();
    XcdBarrier xbar = xcd_barrier_post((unsigned*)ws, bst);
    if (threadIdx.x == 0) {
        const unsigned prev = atomicCAS((unsigned*)ws + XL_MAP + (bx & 7), 0u, xbar.x + 1u);
        if (prev != 0u && prev != xbar.x + 1u) atomicAdd((unsigned*)ws + XL_BAD, 1u);
    }
    bool use_local = false;
    if (args.ph_hi > 100000) grid.sync();

    for (int ph = args.ph_lo; ph < args.ph_hi; ++ph) {
        asm volatile("" : "+s"(kp));
        int tid_ = threadIdx.x; asm volatile("" : "+v"(tid_));
        const int tid = tid_, lane = tid & 63;
        if (ph == 0) {
            LAS float* scr = (LAS float*)lds + wave * (64 * 65);
            cvt_layer(kp, 0, Wb, scr, gw, NGW, lane, 0, 8);
            for (int l = 0; l < DEPTH; ++l) { const int start = (gw + 5 * l) % NGW;
                for (int it = start; it < 256; it += NGW) cvt_item(KIN(kp, 14) + (size_t)l * D * 1024, D, 1024, 16, (bf16_t*)(ws + WS_WCKV) + (size_t)l * 1024 * D, 0, KIN(kp, 12) + (size_t)l * D, scr, it, lane); }
            for (int i = bx * 512 + tid; i < DEPTH * 8192; i += G * 512) { const int l = i >> 13, j = i & 8191, k = j >> 3, c = j & 7;
                ((float*)(ws + WS_WFIMG))[(size_t)l * 8192 + ((k & 15) * 64 + (k >> 4)) * 8 + c] = KIN(kp, 3)[(size_t)l * D * INW + (size_t)k * INW + 1536 + c] * KIN(kp, 2)[(size_t)l * D + k]; }
            norm_rows<false>(KIN(kp, 1), (bf16_t*)(ws + WS_MEMHAT), nullptr, MROWS, gw, NGW, lane);
            norm_rows<true>(KIN(kp, 0), HB, ssp, M, gw, NGW, lane);
        } else {
            const int l = (ph - 1) / 9, sp = (ph - 1) % 9;
            const bf16_t* wl = Wb + (size_t)l * W_LAYER;
            if (sp == 0) {
#define LOGF_JOB() do { LAS float* wf = (LAS float*)lds; __syncthreads(); \
                        { const f32x4* src = (const f32x4*)((const float*)(ws + WS_WFIMG) + (size_t)l * 8192); \
                          _Pragma("unroll") for (int i = 0; i < 4; ++i) *(LAS f32x4*)(wf + (tid + 512 * i) * 4) = src[tid + 512 * i]; } \
                        __syncthreads(); \
                        logf_rows(HB, ssp, wf, KIN(kp, 4) + l * 8, logf, gw, NGW, lane); \
                        __syncthreads(); } while (0)
                LOGF_JOB();
                { pg8::Gemm g{HB, wl + W_IN, M, NIN, D}; pg8::StaticOrder S; S.init(M, NIN, G, bx);
                  pg8::EpiIn E{PB512(0), PB1024(0), KIN(kp, 5) + l * 64, KIN(kp, 6) + l * 64, ssp};
                  for (int rep = 0; rep < REPS(3); ++rep) pg8::gemm_phase<pg8::EpiIn, pg8::StaticOrder, true, true>(lds, g, S, E); }
#undef LOGF_JOB
            } else if (sp == 1) {
                bf16_t* Qb = PB512(P_Q); const bf16_t* Kb = PB512(P_K); const bf16_t* Vb = PB512(P_V);
                for (int rep = 0; rep < REPS(4); ++rep)
                for (int v = vcu; v < 256; v += G) {
                    const int bh = v >> 2, s = v & 3, b = bh >> 3, h = bh & 7;
                    block_cumsum(lds, logf, b, h, tid, lane, wave);
                    for (int half = 0; half < 2; ++half) {
                        const int qb = half ? 7 - s : s;
                        const size_t rb = (size_t)b * T;
                        attn_unit<64, true, 1>(lds, Qb + (rb + qb * 256) * 512 + h * 64, 512, Kb + rb * 512 + h * 64, Vb + rb * 512 + h * 64, 512, (rep + 1 < REPS(4) ? HB : Qb) + (rb + qb * 256) * 512 + h * 64,
                                            4 * (qb + 1), 4 * qb, (const LAS float*)(lds + LDS_CUM), qb * 256, nullptr, nullptr);
                    }
                }
                {
                    const bf16_t* Zb = PB512(P_Z); bf16_t* GBb = PB512(P_GB); const bf16_t* GCb = PB512(P_GC);
                    const float* cw = KIN(kp, 7) + (size_t)l * 3 * 512 + lane * 8;
                    f32x4 w0a = *(const f32x4*)(cw), w0b = *(const f32x4*)(cw + 4), w1a = *(const f32x4*)(cw + 512), w1b = *(const f32x4*)(cw + 516), w2a = *(const f32x4*)(cw + 1024), w2b = *(const f32x4*)(cw + 1028);
                    const int ibase = (NGW == 2048) ? (gw >> 8) * 512 + (gw & 255) : gw, istep = (NGW == 2048) ? 256 : NGW, iend = (NGW == 2048) ? (gw >> 8) * 512 + 512 : M / 4;
                    for (int rep = 0; rep < REPS(11); ++rep)
                    for (int item = ibase; item < iend; item += istep) {
                        const int r0 = item * 4; const size_t eo = (size_t)r0 * 512 + lane * 8;
                        const bool head = (r0 & (T - 1)) == 0;
                        u32x4 zr[6], cr[6], gr[4];
#pragma unroll
                        for (int i = 0; i < 6; ++i) { const size_t o = (head && i < 2) ? eo : eo + (size_t)(i - 2) * 512; zr[i] = *(const u32x4*)(Zb + o); cr[i] = *(const u32x4*)(GCb + o); }
#pragma unroll
                        for (int i = 0; i < 4; ++i) gr[i] = *(const u32x4*)(GBb + eo + i * 512);
                        f32x4 xa[6], xb[6];
#pragma unroll
                        for (int i = 0; i < 6; ++i) { f32x4 za, zb, ca, cb; pg8::unpack8(zr[i], za, zb); pg8::unpack8(cr[i], ca, cb); xa[i] = za * ca; xb[i] = zb * cb;
                            if (head && i < 2) { xa[i] = (f32x4){0.f, 0.f, 0.f, 0.f}; xb[i] = xa[i]; } }
#pragma unroll
                        for (int i = 0; i < 4; ++i) { f32x4 ga, gb2; pg8::unpack8(gr[i], ga, gb2);
                            const f32x4 ya = ga * (w0a * xa[i] + w1a * xa[i + 1] + w2a * xa[i + 2]), yb = gb2 * (w0b * xb[i] + w1b * xb[i + 1] + w2b * xb[i + 2]);
                            *(u32x4*)((rep + 1 < REPS(11) ? HB : GBb) + eo + i * 512) = pg8::pack8(ya, yb); }
                    }
                }
            } else if (sp == 2) {
                pg8::StaticOrder S; S.init(M, D, G, bx);
                pg8::Gemm g{PB512(P_Q), wl + W_UA, M, D, D, PB512(P_GB), 512, 8};
                pg8::EpiGate2 E{PB1024(P_SGA), PB1024(P_SGB), PB1024(P_MRG)};
                for (int rep = 0; rep < REPS(5); ++rep) pg8::gemm_phase<pg8::EpiGate2, pg8::StaticOrder, true, true>(lds, g, S, E);
            } else if (sp == 3 || sp == 6 || sp == 8) {
                const bf16_t* A = (sp == 3) ? PB1024(P_MRG) : (sp == 6) ? PB512(P_QM) : PB2816(P_ACT);
                const bf16_t* Bt = wl + (sp == 3 ? W_O : sp == 6 ? W_CO : W_DN);
                const int K = (sp == 3) ? D : (sp == 6) ? 512 : DFF;
                const float* basef = (l == 0 && sp == 3) ? KIN(kp, 0) : nullptr;
                float* outf = (l == DEPTH - 1 && sp == 8) ? args.out : nullptr;
                pg8::Gemm g{A, Bt, M, D, K}; pg8::StaticOrder S; S.init(M, D, G, bx);
                { pg8::EpiResid E{basef, outf, HB, ssp};
                pg8::gemm_phase<pg8::EpiResid, pg8::StaticOrder, true, true>(lds, g, S, E); }
            } else if (sp == 4) {
                const int GH = G / 2; const bool second = bx >= GH;
                pg8::Gemm g = second ? pg8::Gemm{(const bf16_t*)(ws + WS_MEMHAT), (const bf16_t*)(ws + WS_WCKV), MROWS, 4096, D} : pg8::Gemm{HB, wl + W_CQ, M, 512, D};
                pg8::StaticOrder S; S.init(g.M, g.N, GH, second ? bx - GH : bx);
                pg8::EpiPlain E = second ? pg8::EpiPlain{KVM, 4096, nullptr} : pg8::EpiPlain{PB512(P_QM), 512, ssp};
                if (!second || l == 0) for (int rep = 0; rep < REPS(7); ++rep) pg8::gemm_phase<pg8::EpiPlain, pg8::StaticOrder, true, true>(lds, g, S, E);
                if (second && l >= 1 && l + 1 < DEPTH) cvt_layer(kp, l + 1, Wb + (size_t)(l + 1) * W_LAYER, (LAS float*)lds + wave * (64 * 65), (bx - GH) * 8 + wave, (G - GH) * 8, lane, 0, 6);
            } else if (sp == 5) {
                bf16_t* Qm = PB512(P_QM);
                for (int rep = 0; rep < REPS(8); ++rep)
                for (int v = vcu; v < 256; v += G) {
                    const int b = v >> 5, h = (v >> 3) & 3, qb = v & 7;
                    const bf16_t* Kb = KVM + (size_t)b * MEMT * 4096 + l * 1024 + h * 128;
                    bf16_t* qp = Qm + ((size_t)b * T + qb * 256) * 512 + h * 128;
                    attn_unit<128, false, 4, true>(lds, qp, 512, Kb, Kb + 512, 4096, qp, 4, 0, (const LAS float*)nullptr, 0, KIN(kp, 15) + l * 128, KIN(kp, 16) + l * 128);
                }
            } else {
                pg8::Gemm g{HB, wl + W_GU, M, NGU, D}; pg8::StaticOrder S; S.init(M, NGU, G, bx);
                pg8::EpiSwiglu E{PB2816(P_ACT), ssp};
                for (int rep = 0; rep < REPS(9); ++rep) pg8::gemm_phase<pg8::EpiSwiglu, pg8::StaticOrder, true, true>(lds, g, S, E);
                if (l + 1 < DEPTH && bx >= G / 2) { __syncthreads(); cvt_layer(kp, l + 1, Wb + (size_t)(l + 1) * W_LAYER, (LAS float*)lds + wave * (64 * 65), (bx - G / 2) * 8 + wave, (G - G / 2) * 8, lane, l == 0 ? 0 : 6, 8); }
            }
        }
        if (ph + 1 < args.ph_hi) {
            const int l_ = (ph - 1) / 9, sp_ = (ph - 1) % 9;
            const bool global_seam = !use_local || ph == 0 || sp_ == 8 || (l_ == 0 && sp_ == 4);
            if (global_seam) xcd_barrier(xbar); else { xcd_local_barrier(xbar); if (REPS(13) > 1) { xcd_local_barrier(xbar); xcd_local_barrier(xbar); xcd_local_barrier(xbar); xcd_local_barrier(xbar); } }
            if (ph == 0) {
                if (threadIdx.x == 0) { unsigned okc = 0u;
                    for (unsigned j = 0; j < 16; ++j) { const unsigned c = xb_ld((unsigned*)ws + XB_XCNT(j)); okc += (c == 32u) ? 1u : (c == 0u ? 0u : 100u); }
                    bst[2] = (okc == 8u && G == 256 && xb_ld((unsigned*)ws + XL_BAD) == 0u) ? 1u : 0u;
#ifdef PROBE_PLACEMENT
                    { unsigned long long wait = 0ull; if (okc == 8u) wait += 50000ull; const unsigned nb = xb_ld((unsigned*)ws + XL_BAD); if (nb == 0u) wait += 100000ull; else if (nb >= 128u) wait += 200000ull;
                      if (bx == 0) { const unsigned long long t0 = __builtin_amdgcn_s_memrealtime(); while (__builtin_amdgcn_s_memrealtime() - t0 < wait) __builtin_amdgcn_s_sleep(8); } }
#endif
                }
                __syncthreads();
                use_local = bst[2] != 0u;
#ifdef FORCE_GLOBAL_SEAMS
                use_local = false;
#endif
            }
        }
    }
}

#ifndef MK_ONE_LAUNCH
#define MK_ONE_LAUNCH 1
#endif
extern "C" void kernel_launch(void* const* d_in, const int* in_sizes, int n_in, void* d_out, int out_size, void* d_ws, size_t ws_size, hipStream_t stream) {
    static int grid = 0;
    if (grid == 0) {
        if (n_in != 21 || out_size != M * D || ws_size < WS_END) { fprintf(stderr, "kernel_launch: unexpected shapes (n_in %d, out %d, ws %zu)\n", n_in, out_size, ws_size); grid = -1; return; }
        if (hipFuncSetAttribute((const void*)fwd_kernel, hipFuncAttributeMaxDynamicSharedMemorySize, LDS_BYTES) != hipSuccess) { fprintf(stderr, "kernel_launch: hipFuncSetAttribute failed\n"); grid = -1; return; }
        int dev = 0, cus = 0, per_cu = 0;
        hipGetDevice(&dev); hipDeviceGetAttribute(&cus, hipDeviceAttributeMultiprocessorCount, dev);
        hipOccupancyMaxActiveBlocksPerMultiprocessor(&per_cu, (const void*)fwd_kernel, 512, LDS_BYTES);
        (void)hipGetLastError();
        if (per_cu < 1) per_cu = 1;
        grid = cus;
        if (grid != 256) { fprintf(stderr, "kernel_launch: built for a 256-CU device (one workgroup per CU, one batch element per XCC); got %d CUs\n", cus); grid = -1; return; }
    }
    if (grid < 0) return;
    if (hipMemsetAsync(d_ws, 0, 65536, stream) != hipSuccess) { fprintf(stderr, "kernel_launch: memset of the barrier words failed\n"); return; }
    Args a{};
    for (int i = 0; i < 21; ++i) a.in[i] = (const float*)d_in[i];
    a.out = (float*)d_out; a.ws = (unsigned char*)d_ws;
#if MK_ONE_LAUNCH
    a.ph_lo = 0; a.ph_hi = N_PHASES;
    void* kargs[] = {&a};
    hipError_t e = hipLaunchCooperativeKernel((const void*)fwd_kernel, dim3(grid), dim3(512), kargs, LDS_BYTES, stream);
    if (e != hipSuccess) fprintf(stderr, "cooperative launch failed: %s (grid %d)\n", hipGetErrorString(e), grid);
#else
    for (int ph = 0; ph < N_PHASES; ++ph) { a.ph_lo = ph; a.ph_hi = ph + 1; hipLaunchKernelGGL(fwd_kernel, dim3(grid), dim3(512), LDS_BYTES, stream, a); }
#endif
}
```

```cpp
#include <hip/hip_runtime.h>
#include <hip/hip_cooperative_groups.h>
#include <cstdio>
#include <cstdint>
namespace cg = cooperative_groups;
namespace pg8 {
#define PG8_LAS __attribute__((address_space(3)))
typedef unsigned short bf16_t;
typedef short bf16x8 __attribute__((ext_vector_type(8)));
typedef float f32x4 __attribute__((ext_vector_type(4)));
typedef unsigned u32x4 __attribute__((ext_vector_type(4)));
constexpr int BM = 256, BK = 64, HALF = 128, HTB = HALF * BK * 2  , STAGE_BYTES = 8 * HTB, NXCD = 8, WGM = 8;

__host__ __device__ __forceinline__ int lds_byte(int r, int c) { const int st = (r >> 4) * 2 + (c >> 5), rr = r & 15, cc = c & 31, ob = rr * 64 + cc * 2; return st * 1024 + (ob ^ (((ob >> 9) & 1) << 5)); }
__host__ __device__ __forceinline__ void stage_rc(int b, int& R, int& C) { const int st = b / 1024, sb = b % 1024, swz = sb ^ (((sb >> 9) & 1) << 5); R = (st >> 1) * 16 + swz / 64; C = (st & 1) * 32 + (swz % 64) / 2; }
__host__ __device__ __forceinline__ int perm32(int rho) { const int n = rho >> 4, i = rho & 15; return 8 * (i >> 2) + 4 * n + (i & 3); }

struct Unit { int pm, pn; };
struct Gemm { const bf16_t* A; const bf16_t* Bt; int M, N, K; const bf16_t* A2; int lda, ksplit; };

struct StaticOrder {
    int nM, nN, nwg, G, c;
    __host__ __device__ void init(int M, int N, int G_, int c_) { nM = M / BM; nN = N / BM; nwg = nM * nN; G = G_; c = c_; }
    __host__ __device__ bool next(int i, Unit& u) const {
        const long L = (long)i * G + c; if (L >= nwg) return false;
        int wgid = (int)L; { const int q = nwg / NXCD, r = nwg % NXCD, xcd = wgid % NXCD, off = wgid / NXCD; wgid = (xcd < r ? xcd * (q + 1) : r * (q + 1) + (xcd - r) * q) + off; }
        const int nig = WGM * nN, gid = wgid / nig, fm = gid * WGM, gsz = (nM - fm) < WGM ? (nM - fm) : WGM;
        u.pm = fm + ((wgid % nig) % gsz); u.pn = (wgid % nig) / gsz; return true;
    }
    __device__ __forceinline__ void a_ready(const Unit&) const {}
    __device__ __forceinline__ void done(const Unit&) const {}
};

typedef unsigned u32x2 __attribute__((ext_vector_type(2)));
__device__ __forceinline__ float shx(float v, int lane, int m) { return __int_as_float(__builtin_amdgcn_ds_bpermute((lane ^ m) << 2, __float_as_int(v))); }
__device__ __forceinline__ float shup(float v, int lane, int d) { return __int_as_float(__builtin_amdgcn_ds_bpermute((lane - d) << 2, __float_as_int(v))); }
__device__ __forceinline__ unsigned cvt_pk_bf16(float lo, float hi) { unsigned r; asm volatile("v_cvt_pk_bf16_f32 %0, %1, %2" : "=v"(r) : "v"(lo), "v"(hi)); return r; }
__device__ __forceinline__ float bf_lo(unsigned w) { return __uint_as_float(w << 16); }
__device__ __forceinline__ float bf_hi(unsigned w) { return __uint_as_float(w & 0xffff0000u); }
__device__ __forceinline__ u32x4 pack8(const f32x4 v0, const f32x4 v1) { u32x4 w; w.x = cvt_pk_bf16(v0[0], v0[1]); w.y = cvt_pk_bf16(v0[2], v0[3]); w.z = cvt_pk_bf16(v1[0], v1[1]); w.w = cvt_pk_bf16(v1[2], v1[3]); return w; }
__device__ __forceinline__ void unpack8(const u32x4 w, f32x4& v0, f32x4& v1) { v0 = (f32x4){bf_lo(w.x), bf_hi(w.x), bf_lo(w.y), bf_hi(w.y)}; v1 = (f32x4){bf_lo(w.z), bf_hi(w.z), bf_lo(w.w), bf_hi(w.w)}; }
__device__ __forceinline__ float sigmoidf_(float x) { return __builtin_amdgcn_rcpf(1.0f + __builtin_amdgcn_exp2f(-1.4426950408889634f * x)); }

constexpr int MTOK = 16384;
constexpr float QSCALE = 0.125f * 1.4426950408889634f;
constexpr float NEPS = 1e-6f;

__device__ __forceinline__ float row_rstd(const float* ssp, int row) { const f32x4* p = (const f32x4*)(ssp + (size_t)row * 16); const f32x4 a = (p[0] + p[1]) + (p[2] + p[3]); return __builtin_amdgcn_rsqf(((a[0] + a[1]) + (a[2] + a[3])) * (1.0f / 1024.0f) + NEPS); }

struct EpiPlain {
    static constexpr bool PERM = true, AFTER_DRAIN = false, HAS_MID = false, IDEM = true;
    bf16_t* O; int ldc; const float* ssp;
    __device__ __forceinline__ void operator()(const f32x4 (&acc)[2][2][4][2], const Unit& u, int wr, int wc, int fr, int fq) const {
        const int row0 = u.pm * BM + wr * 64 + fr, col0 = u.pn * BM + wc * 32 + 8 * fq;
#pragma unroll
        for (int ai = 0; ai < 2; ++ai)
#pragma unroll
            for (int m = 0; m < 4; ++m) { const int row = row0 + ai * HALF + m * 16; bf16_t* rowp = O + (size_t)row * ldc + col0; const float rs = ssp ? row_rstd(ssp, row) : 1.0f;
#pragma unroll
                for (int bj = 0; bj < 2; ++bj) *(u32x4*)(rowp + bj * HALF) = pack8(acc[ai][bj][m][0] * rs, acc[ai][bj][m][1] * rs); }
    }
};

struct EpiIn {
    static constexpr bool PERM = true, AFTER_DRAIN = false, HAS_MID = false, IDEM = true;
    bf16_t* P512; bf16_t* P1024; const float* qg; const float* kg; const float* ssp;
    const PG8_LAS float* lrs; int pm0;
    __device__ __forceinline__ void operator()(const f32x4 (&acc)[2][2][4][2], const Unit& u, int wr, int wc, int fr, int fq) const {
        const int pn = u.pn; int mode, ldc, ct; bf16_t* base;
        if (pn < 12) { const int b = pn >> 1; base = P512 + (size_t)b * (1u << 20); ldc = 512; ct = (pn & 1) * 256; mode = (b == 0) ? 1 : (b == 1) ? 2 : 0; }
        else { const int b = (pn - 12) >> 2; base = P1024 + (size_t)(6 + 2 * b) * (1u << 20); ldc = 1024; ct = ((pn - 12) & 3) * 256; mode = 3; }
        const int row0 = u.pm * BM + wr * 64 + fr, dcol = ct + 64 * wc + 8 * fq;
        f32x4 gv[2][2];
        const bool inlds = (u.pm == pm0);
        if (mode == 1 || mode == 2) {
            if (inlds) { const PG8_LAS float* g = lrs + (mode == 1 ? 256 : 320);
#pragma unroll
                for (int bj = 0; bj < 2; ++bj)
#pragma unroll
                    for (int n = 0; n < 2; ++n) gv[bj][n] = *(const PG8_LAS f32x4*)(g + 32 * bj + 8 * fq + 4 * n);
            } else { const float* g = (mode == 1) ? qg : kg; const float sc = (mode == 1) ? QSCALE : 1.0f;
#pragma unroll
                for (int bj = 0; bj < 2; ++bj)
#pragma unroll
                    for (int n = 0; n < 2; ++n) gv[bj][n] = *(const f32x4*)(g + 32 * bj + 8 * fq + 4 * n) * sc; } }
#pragma unroll
        for (int ai = 0; ai < 2; ++ai)
#pragma unroll
            for (int m = 0; m < 4; ++m) {
                f32x4 v[2][2]; const float rsr = inlds ? lrs[wr * 64 + fr + ai * HALF + m * 16] : row_rstd(ssp, row0 + ai * HALF + m * 16);
#pragma unroll
                for (int bj = 0; bj < 2; ++bj)
#pragma unroll
                    for (int n = 0; n < 2; ++n) v[bj][n] = (mode == 3) ? acc[ai][bj][m][n] * (-1.4426950408889634f * rsr) : acc[ai][bj][m][n] * rsr;
                if (mode == 1 || mode == 2) {
                    float ss = 0.f;
#pragma unroll
                    for (int bj = 0; bj < 2; ++bj)
#pragma unroll
                        for (int n = 0; n < 2; ++n) { const f32x4 x = v[bj][n]; ss += (x[0] * x[0] + x[1] * x[1]) + (x[2] * x[2] + x[3] * x[3]); }
                    { const int ln_ = fr + 16 * fq; ss += shx(ss, ln_, 16); ss += shx(ss, ln_, 32); }
                    const float rs = __builtin_amdgcn_rsqf(ss * (1.0f / 64.0f) + NEPS);
#pragma unroll
                    for (int bj = 0; bj < 2; ++bj)
#pragma unroll
                        for (int n = 0; n < 2; ++n) v[bj][n] = v[bj][n] * rs * gv[bj][n];
                } else if (mode == 3) {
#pragma unroll
                    for (int bj = 0; bj < 2; ++bj)
#pragma unroll
                        for (int n = 0; n < 2; ++n) { f32x4 x = v[bj][n];
                            x[0] = __builtin_amdgcn_exp2f(x[0]); x[1] = __builtin_amdgcn_exp2f(x[1]); x[2] = __builtin_amdgcn_exp2f(x[2]); x[3] = __builtin_amdgcn_exp2f(x[3]); x = x + 1.0f;
                            x[0] = __builtin_amdgcn_rcpf(x[0]); x[1] = __builtin_amdgcn_rcpf(x[1]); x[2] = __builtin_amdgcn_rcpf(x[2]); x[3] = __builtin_amdgcn_rcpf(x[3]); v[bj][n] = x; }
                }
                bf16_t* rowp = base + (size_t)(row0 + ai * HALF + m * 16) * ldc + dcol;
#pragma unroll
                for (int bj = 0; bj < 2; ++bj) *(u32x4*)(rowp + 32 * bj) = pack8(v[bj][0], v[bj][1]);
            }
    }
};

template <bool ADD> struct EpiGate {
    static constexpr bool PERM = true, AFTER_DRAIN = false, HAS_MID = false, IDEM = !ADD;
    const bf16_t* G; bf16_t* Mg;
    __device__ __forceinline__ void operator()(const f32x4 (&acc)[2][2][4][2], const Unit& u, int wr, int wc, int fr, int fq) const {
        const int row0 = u.pm * BM + wr * 64 + fr, col0 = u.pn * BM + wc * 32 + 8 * fq;
#pragma unroll
        for (int ai = 0; ai < 2; ++ai)
#pragma unroll
            for (int m = 0; m < 4; ++m) { const size_t off = (size_t)(row0 + ai * HALF + m * 16) * 1024 + col0;
#pragma unroll
                for (int bj = 0; bj < 2; ++bj) { f32x4 g0, g1; unpack8(*(const u32x4*)(G + off + bj * HALF), g0, g1);
                    f32x4 r0 = g0 * acc[ai][bj][m][0], r1 = g1 * acc[ai][bj][m][1];
                    if (ADD) { f32x4 p0, p1; unpack8(*(const u32x4*)(Mg + off + bj * HALF), p0, p1); r0 += p0; r1 += p1; }
                    *(u32x4*)(Mg + off + bj * HALF) = pack8(r0, r1); } }
    }
};

struct EpiResid {
    static constexpr bool PERM = true, AFTER_DRAIN = false, HAS_MID = false, IDEM = false;
    const float* basef; float* outf; bf16_t* HB; float* ssp;
    __device__ __forceinline__ void operator()(const f32x4 (&acc)[2][2][4][2], const Unit& u, int wr, int wc, int fr, int fq) const {
        const int row0 = u.pm * BM + wr * 64 + fr, col0 = u.pn * BM + wc * 32 + 8 * fq;
#pragma unroll
        for (int ai = 0; ai < 2; ++ai)
#pragma unroll
            for (int m = 0; m < 4; ++m) { const int row = row0 + ai * HALF + m * 16; const size_t off = (size_t)row * 1024 + col0; float ss = 0.f;
#pragma unroll
                for (int bj = 0; bj < 2; ++bj) { f32x4 b0, b1;
                    if (basef) { b0 = *(const f32x4*)(basef + off + bj * HALF); b1 = *(const f32x4*)(basef + off + bj * HALF + 4); } else unpack8(*(const u32x4*)(HB + off + bj * HALF), b0, b1);
                    const f32x4 o0 = b0 + acc[ai][bj][m][0], o1 = b1 + acc[ai][bj][m][1];
                    if (outf) { *(f32x4*)(outf + off + bj * HALF) = o0; *(f32x4*)(outf + off + bj * HALF + 4) = o1; }
                    ss += ((o0[0] * o0[0] + o0[1] * o0[1]) + (o0[2] * o0[2] + o0[3] * o0[3])) + ((o1[0] * o1[0] + o1[1] * o1[1]) + (o1[2] * o1[2] + o1[3] * o1[3]));
                    *(u32x4*)(HB + off + bj * HALF) = pack8(o0, o1); }
                { const int ln_ = fr + 16 * fq; ss += shx(ss, ln_, 16); ss += shx(ss, ln_, 32); }
                if (fq == 0) ssp[(size_t)row * 16 + u.pn * 4 + wc] = ss;
                if (m & 1) asm volatile("" ::: "memory"); }
    }
};

struct EpiGate2 {
    static constexpr bool PERM = true, AFTER_DRAIN = false, HAS_MID = true, IDEM = true;
    const bf16_t* GA; const bf16_t* GB; bf16_t* Mg;
    __device__ __forceinline__ void mid(f32x4 (&acc)[2][2][4][2], const Unit& u, int wr, int wc, int fr, int fq) const {
        int row0 = u.pm * BM + wr * 64 + fr, col0 = u.pn * BM + wc * 32 + 8 * fq;
        asm volatile("" : "+v"(row0), "+v"(col0));
#pragma unroll
        for (int ai = 0; ai < 2; ++ai)
#pragma unroll
            for (int m = 0; m < 4; ++m) { const size_t off = (size_t)(row0 + ai * HALF + m * 16) * 1024 + col0;
#pragma unroll
                for (int bj = 0; bj < 2; ++bj) { f32x4 a0, a1, b0, b1; unpack8(*(const u32x4*)(GA + off + bj * HALF), a0, a1); unpack8(*(const u32x4*)(GB + off + bj * HALF), b0, b1);
#pragma unroll
                    for (int e = 0; e < 4; ++e) { acc[ai][bj][m][0][e] *= a0[e] * __builtin_amdgcn_rcpf(fmaxf(b0[e], 1e-20f)); acc[ai][bj][m][1][e] *= a1[e] * __builtin_amdgcn_rcpf(fmaxf(b1[e], 1e-20f)); }
                    asm volatile("" ::: "memory"); } }
    }
    __device__ __forceinline__ void operator()(const f32x4 (&acc)[2][2][4][2], const Unit& u, int wr, int wc, int fr, int fq) const {
        int row0 = u.pm * BM + wr * 64 + fr, col0 = u.pn * BM + wc * 32 + 8 * fq;
        asm volatile("" : "+v"(row0), "+v"(col0));
#pragma unroll
        for (int ai = 0; ai < 2; ++ai)
#pragma unroll
            for (int m = 0; m < 4; ++m) { const size_t off = (size_t)(row0 + ai * HALF + m * 16) * 1024 + col0;
#pragma unroll
                for (int bj = 0; bj < 2; ++bj) { f32x4 b0, b1; unpack8(*(const u32x4*)(GB + off + bj * HALF), b0, b1);
#pragma unroll
                    for (int e = 0; e < 4; ++e) { b0[e] = fmaxf(b0[e], 1e-20f); b1[e] = fmaxf(b1[e], 1e-20f); }
                    *(u32x4*)(Mg + off + bj * HALF) = pack8(acc[ai][bj][m][0] * b0, acc[ai][bj][m][1] * b1); } }
    }
};

typedef float f32x2 __attribute__((ext_vector_type(2)));
struct EpiSwiglu {
    static constexpr bool PERM = true, AFTER_DRAIN = false, HAS_MID = false, IDEM = true;
    bf16_t* O; const float* ssp; const PG8_LAS float* lrs; int pm0;
    __device__ __forceinline__ void operator()(const f32x4 (&acc)[2][2][4][2], const Unit& u, int wr, int wc, int fr, int fq) const {
        const int row0 = u.pm * BM + wr * 64 + fr, col0 = u.pn * HALF + wc * 32 + 8 * fq; const bool inlds = (u.pm == pm0);
#pragma unroll
        for (int ai = 0; ai < 2; ++ai)
#pragma unroll
            for (int m = 0; m < 4; ++m) { const float rs = inlds ? lrs[wr * 64 + fr + ai * HALF + m * 16] : row_rstd(ssp, row0 + ai * HALF + m * 16); const float nrl = -1.4426950408889634f * rs, rs2 = rs * rs; u32x4 w;
#pragma unroll
                for (int n = 0; n < 2; ++n)
#pragma unroll
                    for (int h = 0; h < 2; ++h) { const f32x2 g = {acc[ai][0][m][n][2 * h], acc[ai][0][m][n][2 * h + 1]}, v = {acc[ai][1][m][n][2 * h], acc[ai][1][m][n][2 * h + 1]};
                        const f32x2 t = g * nrl; f32x2 ex; ex.x = __builtin_amdgcn_exp2f(t.x); ex.y = __builtin_amdgcn_exp2f(t.y);
                        const f32x2 d = ex + 1.0f; f32x2 r; r.x = __builtin_amdgcn_rcpf(d.x); r.y = __builtin_amdgcn_rcpf(d.y);
                        const f32x2 o = (g * v) * (r * rs2);
                        w[2 * n + h] = cvt_pk_bf16(o.x, o.y); }
                *(u32x4*)(O + (size_t)(row0 + ai * HALF + m * 16) * 2816 + col0) = w; }
    }
};

template <class Epi, class Sched, bool ALIGN_EPI = false, bool SP2 = false>
__device__ __forceinline__ void gemm_phase(PG8_LAS unsigned char* lds, const Gemm g, const Sched& S, const Epi& E) {
    int tid_ = threadIdx.x; asm volatile("" : "+v"(tid_));
    const int tid = tid_, wid = __builtin_amdgcn_readfirstlane(tid >> 6), lane = tid & 63, wr = wid >> 2, wc = wid & 3, fr = lane & 15, fq = lane >> 4;
    const int K = g.K, nt = K / BK, lda = g.lda ? g.lda : K, ksp = g.ksplit ? g.ksplit : nt + 8;
    unsigned voffA[2], voffB[2];
#pragma unroll
    for (int i = 0; i < 2; ++i) { int R, C; stage_rc(tid * 16 + i * 8192, R, C); const int Rb = Epi::PERM ? ((R & ~31) + perm32(R & 31)) : R;
        voffA[i] = (unsigned)(R * lda + C) * 2u; voffB[i] = (unsigned)(Rb * K + C) * 2u; }
    const size_t kstep = (size_t)(BK * 2);
    const size_t hstepB = (size_t)HALF * K * 2, hstepA = (size_t)HALF * lda * 2;
    const size_t tstepB = 2 * hstepB, tstepA = 2 * hstepA;
    const unsigned ldsw = (unsigned)wid * 1024u;
    const int aoff = lds_byte(wr * 64 + fr, fq * 8), boff = lds_byte(wc * 32 + fr, fq * 8);
#define PG8_SA(b, h) (((b) * 2 + (h)) * HTB)
#define PG8_SB(b, h) ((4 + (b) * 2 + (h)) * HTB)
#define PG8_STAGE(bufoff, gbase, voff) do { _Pragma("unroll") for (int _i = 0; _i < 2; ++_i) \
        __builtin_amdgcn_global_load_lds((const unsigned*)((const char*)(gbase) + (voff)[_i]), (PG8_LAS unsigned*)(lds + (bufoff) + ldsw + _i * 8192), 16, 0, 0); } while (0)
#define PG8_LDA(dst, b, h) do { _Pragma("unroll") for (int m = 0; m < 4; ++m) _Pragma("unroll") for (int k = 0; k < 2; ++k) dst[m][k] = *(const PG8_LAS bf16x8*)(lds + PG8_SA(b, h) + aoff + m * 2048 + k * 1024); } while (0)
#define PG8_LDB(dst, b, h) do { _Pragma("unroll") for (int n = 0; n < 2; ++n) _Pragma("unroll") for (int k = 0; k < 2; ++k) dst[n][k] = *(const PG8_LAS bf16x8*)(lds + PG8_SB(b, h) + boff + n * 2048 + k * 1024); } while (0)
#define PG8_MMA(ai, bj, At, Bt) do { __builtin_amdgcn_s_setprio(1); _Pragma("unroll") for (int m = 0; m < 4; ++m) _Pragma("unroll") for (int n = 0; n < 2; ++n) _Pragma("unroll") for (int k = 0; k < 2; ++k) \
        acc[ai][bj][m][n] = __builtin_amdgcn_mfma_f32_16x16x32_bf16(Bt[n][k], At[m][k], acc[ai][bj][m][n], 0, 0, 0); __builtin_amdgcn_s_setprio(0); } while (0)
#define PG8_WAIT_V(n) asm volatile("s_waitcnt vmcnt(" #n ")" ::: "memory")
#define PG8_WAIT_L(n) asm volatile("s_waitcnt lgkmcnt(" #n ")" ::: "memory")
#define PG8_BAR __builtin_amdgcn_s_barrier()
#define PG8_SCHED __builtin_amdgcn_sched_barrier(0)
    Unit cur, nxt; int ui = 0;
    if (!S.next(0, cur)) return;
    f32x4 acc[2][2][4][2];
#pragma unroll
    for (int a = 0; a < 2; ++a)
#pragma unroll
        for (int b = 0; b < 2; ++b)
#pragma unroll
            for (int m = 0; m < 4; ++m)
#pragma unroll
                for (int n = 0; n < 2; ++n) acc[a][b][m][n] = (f32x4){0.f, 0.f, 0.f, 0.f};
    bf16x8 At[4][2], B0[2][2], B1[2][2];
    const char* cA = (const char*)g.A + (size_t)cur.pm * tstepA; const char* cB = (const char*)g.Bt + (size_t)cur.pn * tstepB;
    const char* cA2 = g.A2 ? (const char*)g.A2 + (size_t)cur.pm * tstepA - (size_t)ksp * kstep : cA;
    S.a_ready(cur);
    if constexpr (SP2) {
        PG8_STAGE(PG8_SB(0, 0), cB, voffB); PG8_STAGE(PG8_SB(0, 1), cB + hstepB, voffB); PG8_STAGE(PG8_SA(0, 0), cA, voffA); PG8_STAGE(PG8_SA(0, 1), cA + hstepA, voffA);
        if (wr == 1) PG8_BAR;
        PG8_WAIT_V(2); PG8_BAR;
        PG8_STAGE(PG8_SB(1, 0), cB + kstep, voffB); PG8_STAGE(PG8_SA(1, 0), cA + kstep, voffA); PG8_STAGE(PG8_SB(1, 1), cB + hstepB + kstep, voffB);
        PG8_WAIT_V(6); PG8_BAR;
    } else {
        PG8_STAGE(PG8_SB(0, 0), cB, voffB); PG8_STAGE(PG8_SA(0, 0), cA, voffA); PG8_STAGE(PG8_SB(0, 1), cB + hstepB, voffB); PG8_STAGE(PG8_SA(0, 1), cA + hstepA, voffA);
        if (wr == 1) PG8_BAR;
        PG8_WAIT_V(4); PG8_BAR;
        PG8_STAGE(PG8_SB(1, 0), cB + kstep, voffB); PG8_STAGE(PG8_SA(1, 0), cA + kstep, voffA); PG8_STAGE(PG8_SB(1, 1), cB + hstepB + kstep, voffB);
        PG8_WAIT_V(6); PG8_BAR;
    }
    for (;;) {
        const bool has_next = S.next(ui + 1, nxt);
        const char* nA = has_next ? (const char*)g.A + (size_t)nxt.pm * tstepA : cA; const char* nB = has_next ? (const char*)g.Bt + (size_t)nxt.pn * tstepB : cB;
        const char* nA2 = (has_next && g.A2) ? (const char*)g.A2 + (size_t)nxt.pm * tstepA - (size_t)ksp * kstep : (has_next ? nA : cA2);
        for (int t = 0; t < nt; t += 2) {
            const bool last = (t == nt - 2);
            if constexpr (Epi::HAS_MID) { if (t == ksp) E.mid(acc, cur, wr, wc, fr, fq); }
            const char* a1 = (t + 1 < ksp ? cA : cA2) + (size_t)(t + 1) * kstep;
            const char* a2 = last ? nA : (t + 2 < ksp ? cA : cA2) + (size_t)(t + 2) * kstep; const char* b2 = last ? nB : cB + (size_t)(t + 2) * kstep;
            const char* a3 = a2 + kstep; const char* b3 = b2 + kstep;
            if (last && has_next) S.a_ready(nxt);
            if constexpr (SP2) {
            PG8_LDB(B0, 0, 0); PG8_LDB(B1, 0, 1); PG8_SCHED; PG8_LDA(At, 0, 0); PG8_STAGE(PG8_SA(1, 1), a1 + hstepA, voffA);
            PG8_WAIT_V(8); PG8_WAIT_L(0); PG8_BAR; PG8_MMA(0, 0, At, B0); PG8_MMA(0, 1, At, B1); PG8_BAR; PG8_SCHED;
            PG8_LDA(At, 0, 1); PG8_STAGE(PG8_SB(0, 0), b2, voffB); PG8_STAGE(PG8_SB(0, 1), b2 + hstepB, voffB); PG8_STAGE(PG8_SA(0, 0), a2, voffA);
            PG8_WAIT_V(8); PG8_WAIT_L(0); PG8_BAR; PG8_MMA(1, 0, At, B0); PG8_MMA(1, 1, At, B1); PG8_BAR; PG8_SCHED;
            PG8_LDB(B0, 1, 0); PG8_LDB(B1, 1, 1); PG8_SCHED; PG8_LDA(At, 1, 0); PG8_STAGE(PG8_SA(0, 1), a2 + hstepA, voffA);
            PG8_WAIT_V(8); PG8_WAIT_L(0); PG8_BAR; PG8_MMA(0, 0, At, B0); PG8_MMA(0, 1, At, B1); PG8_BAR; PG8_SCHED;
            PG8_LDA(At, 1, 1); PG8_STAGE(PG8_SB(1, 0), b3, voffB); PG8_STAGE(PG8_SB(1, 1), b3 + hstepB, voffB); PG8_STAGE(PG8_SA(1, 0), a3, voffA);
            PG8_WAIT_V(8); PG8_WAIT_L(0); PG8_BAR; PG8_MMA(1, 0, At, B0); PG8_MMA(1, 1, At, B1); PG8_BAR; PG8_SCHED;
            } else {
            PG8_LDB(B0, 0, 0); PG8_SCHED; PG8_LDA(At, 0, 0); PG8_STAGE(PG8_SA(1, 1), a1 + hstepA, voffA);
            PG8_WAIT_L(8); PG8_BAR; PG8_WAIT_L(0); PG8_MMA(0, 0, At, B0); PG8_BAR; PG8_SCHED;
            PG8_LDB(B1, 0, 1); PG8_STAGE(PG8_SB(0, 0), b2, voffB);
            PG8_BAR; PG8_WAIT_L(0); PG8_MMA(0, 1, At, B1); PG8_BAR;
            PG8_LDA(At, 0, 1); PG8_STAGE(PG8_SA(0, 0), a2, voffA);
            PG8_BAR; PG8_WAIT_L(0); PG8_MMA(1, 0, At, B0); PG8_BAR; PG8_SCHED;
            PG8_STAGE(PG8_SB(0, 1), b2 + hstepB, voffB);
            PG8_WAIT_V(6); PG8_BAR; PG8_MMA(1, 1, At, B1); PG8_BAR;
            PG8_LDB(B0, 1, 0); PG8_SCHED; PG8_LDA(At, 1, 0); PG8_STAGE(PG8_SA(0, 1), a2 + hstepA, voffA);
            PG8_WAIT_L(8); PG8_BAR; PG8_WAIT_L(0); PG8_MMA(0, 0, At, B0); PG8_BAR; PG8_SCHED;
            PG8_LDB(B1, 1, 1); PG8_STAGE(PG8_SB(1, 0), b3, voffB);
            PG8_BAR; PG8_WAIT_L(0); PG8_MMA(0, 1, At, B1); PG8_BAR;
            PG8_LDA(At, 1, 1); PG8_STAGE(PG8_SA(1, 0), a3, voffA);
            PG8_BAR; PG8_WAIT_L(0); PG8_MMA(1, 0, At, B0); PG8_BAR; PG8_SCHED;
            PG8_STAGE(PG8_SB(1, 1), b3 + hstepB, voffB);
            PG8_WAIT_V(6); PG8_BAR; PG8_MMA(1, 1, At, B1); PG8_BAR;
            }
        }
        if constexpr (ALIGN_EPI) { if (wr == 0) PG8_BAR; }
        if constexpr (!Epi::AFTER_DRAIN) { E(acc, cur, wr, wc, fr, fq);
#ifdef EPI_TWICE
            if constexpr (Epi::IDEM) { asm volatile("" ::: "memory"); E(acc, cur, wr, wc, fr, fq); }
#endif
            S.done(cur); }
        if (!has_next) break;
#pragma unroll
        for (int a = 0; a < 2; ++a)
#pragma unroll
            for (int b = 0; b < 2; ++b)
#pragma unroll
                for (int m = 0; m < 4; ++m)
#pragma unroll
                    for (int n = 0; n < 2; ++n) acc[a][b][m][n] = (f32x4){0.f, 0.f, 0.f, 0.f};
        cur = nxt; cA = nA; cA2 = nA2; cB = nB; ++ui;
        if constexpr (ALIGN_EPI) { if (wr == 1) PG8_BAR; }
    }
    PG8_WAIT_V(0);
    if constexpr (!ALIGN_EPI) { if (wr == 0) PG8_BAR; }
    PG8_BAR;
    if constexpr (Epi::AFTER_DRAIN) { E.fused(acc, cur, wr, wc, fr, fq, lds, wid, lane); S.done(cur); }
#undef PG8_SA
#undef PG8_SB
#undef PG8_STAGE
#undef PG8_LDA
#undef PG8_LDB
#undef PG8_MMA
#undef PG8_WAIT_V
#undef PG8_WAIT_L
#undef PG8_BAR
#undef PG8_SCHED
}
}

#define LAS __attribute__((address_space(3)))
using pg8::bf16_t; using pg8::bf16x8; using pg8::f32x4; using pg8::u32x4;
typedef float f32x16 __attribute__((ext_vector_type(16)));
typedef short v4i16_t __attribute__((ext_vector_type(4)));
typedef unsigned u32x2 __attribute__((ext_vector_type(2)));

constexpr int M = 16384, T = 2048, NBATCH = 8, D = 1024, DEPTH = 4, INW = 5128, NIN = 5120, DFF = 2816, NGU = 5632, MEMT = 256, MROWS = NBATCH * MEMT;
constexpr float LOG2E = 1.4426950408889634f;
constexpr float MSCALE = 0.08838834764831845f * 1.4426950408889634f;
constexpr size_t MiB = 1u << 20;
constexpr size_t WS_LOGF = 512 * 1024;
constexpr size_t WS_SSP = 1 * MiB;
constexpr size_t WS_W = 2 * MiB;
constexpr size_t W_IN = 0, W_UA = 5242880, W_UB = 5767168, W_O = 6291456, W_CQ = 7340032, W_CO = 7864320, W_GU = 8388608, W_DN = 14155776, W_LAYER = 17039360;
constexpr size_t WS_U = WS_W + 130 * MiB;
constexpr size_t WS_KVM = WS_U + 32 * MiB;
constexpr size_t WS_P = WS_KVM + 16 * MiB;
constexpr size_t WS_MEMHAT = WS_P + 160 * MiB;
constexpr size_t WS_WCKV = WS_MEMHAT + 4 * MiB;
constexpr size_t WS_WFIMG = 256 * 1024;
constexpr size_t WS_END = WS_WCKV + 8 * MiB;
static_assert(W_LAYER * 2 * 4 == 130 * MiB && WS_END == 369098752, "workspace map");
constexpr size_t PB_STRIDE = 20 * MiB;
constexpr size_t P_Q = 0, P_K = 2 * MiB, P_V = 4 * MiB, P_Z = 6 * MiB, P_GB = 8 * MiB, P_GC = 10 * MiB, P_SGA = 12 * MiB, P_SGB = 16 * MiB;
constexpr size_t P_MRG = P_K;
constexpr size_t P_QM = P_Z;
constexpr size_t P_ACT = 0;
constexpr int LDS_RSTD = 139264;
constexpr int LDS_BYTES = 147456;

__device__ __forceinline__ float wave_sum(float v, int lane) {
#pragma unroll
    for (int o = 1; o < 64; o <<= 1) v += pg8::shx(v, lane, o);
    return v;
}
__device__ __forceinline__ unsigned pk2(float lo, float hi) { return pg8::cvt_pk_bf16(lo, hi); }

__device__ __forceinline__ int srcmap(int map, int n) {
    if (map == 1) { const int tile = n >> 8, c = n & 255; const int o = tile * 256 + 64 * ((c >> 5) & 3) + 32 * (c >> 7) + (c & 31); return o >= 1536 ? o + 8 : o; }
    if (map == 2) { const int tile = n >> 8, c = n & 255; return c < 128 ? tile * 128 + c : DFF + tile * 128 + (c - 128); }
    return n;
}
__device__ __forceinline__ void cvt_item(const float* W, int K, int Nsrc, int nblk, bf16_t* dst, int map, const float* gain, LAS float* scr, int item, int lane, int ldd = 0) {
    if (ldd == 0) ldd = K;
    const int kb = item / nblk, nb = item % nblk, k0 = 64 * kb, n0 = 64 * nb;
    const int nc = (lane & 15) * 4, kr = lane >> 4;
    const int sc = srcmap(map, n0 + nc);
    const float* src = W + (size_t)(k0 + kr) * Nsrc + sc;
    f32x4 v[16];
#pragma unroll
    for (int i = 0; i < 16; ++i) v[i] = *(const f32x4*)(src + (size_t)(4 * i) * Nsrc);
    if (gain) {
#pragma unroll
        for (int i = 0; i < 16; ++i) v[i] = v[i] * gain[k0 + kr + 4 * i];
    }
#pragma unroll
    for (int i = 0; i < 16; ++i) { LAS float* p = scr + (kr + 4 * i) * 65 + nc; p[0] = v[i][0]; p[1] = v[i][1]; p[2] = v[i][2]; p[3] = v[i][3]; }
    asm volatile("s_waitcnt lgkmcnt(0)" ::: "memory");
    const int c = lane & 7;
#pragma unroll
    for (int j = 0; j < 8; ++j) { const int n = (lane >> 3) + 8 * j; const LAS float* s = scr + (8 * c) * 65 + n;
        u32x4 o; o.x = pk2(s[0], s[65]); o.y = pk2(s[2 * 65], s[3 * 65]); o.z = pk2(s[4 * 65], s[5 * 65]); o.w = pk2(s[6 * 65], s[7 * 65]);
        *(u32x4*)(dst + (size_t)(n0 + n) * ldd + k0 + 8 * c) = o; }
    asm volatile("s_waitcnt lgkmcnt(0)" ::: "memory");
}
#define KARG __attribute__((address_space(4)))
typedef const char KARG* kargp_t;
#define KIN(kp_, k_) (*(const float* const KARG*)((kp_) + 8 * (k_)))
struct CvtJob { const float* W; int K, Nsrc, Ndst, map; bf16_t* dst; const float* gain; int ldd; };
__device__ __forceinline__ void cvt_layer(kargp_t kp, int l, bf16_t* wl, LAS float* scr, int gw, int NGW, int lane, int j0, int j1) {
    int pre = 0;
    for (int j = j0; j < j1; ++j) {
        CvtJob jb;
        switch (j) {
        case 0: jb = CvtJob{KIN(kp, 3) + (size_t)l * D * INW, D, INW, NIN, 1, wl + W_IN, KIN(kp, 2) + (size_t)l * D, 0}; break;
        case 1: jb = CvtJob{KIN(kp, 8) + (size_t)l * 512 * D, 512, D, D, 0, wl + W_UA, nullptr, 1024}; break;
        case 2: jb = CvtJob{KIN(kp, 9) + (size_t)l * 512 * D, 512, D, D, 0, wl + W_UA + 512, nullptr, 1024}; break;
        case 3: jb = CvtJob{KIN(kp, 10) + (size_t)l * D * D, D, D, D, 0, wl + W_O, nullptr, 0}; break;
        case 4: jb = CvtJob{KIN(kp, 13) + (size_t)l * D * 512, D, 512, 512, 0, wl + W_CQ, KIN(kp, 11) + (size_t)l * D, 0}; break;
        case 5: jb = CvtJob{KIN(kp, 17) + (size_t)l * 512 * D, 512, D, D, 0, wl + W_CO, nullptr, 0}; break;
        case 6: jb = CvtJob{KIN(kp, 19) + (size_t)l * D * NGU, D, NGU, NGU, 2, wl + W_GU, KIN(kp, 18) + (size_t)l * D, 0}; break;
        default: jb = CvtJob{KIN(kp, 20) + (size_t)l * DFF * D, DFF, D, D, 0, wl + W_DN, nullptr, 0}; break;
        }
        const int nblk = jb.Ndst / 64, nitems = (jb.K / 64) * nblk;
        const int start = (gw - pre % NGW + NGW) % NGW;
        for (int it = start; it < nitems; it += NGW) cvt_item(jb.W, jb.K, jb.Nsrc, nblk, jb.dst, jb.map, jb.gain, scr, it, lane, jb.ldd);
        pre += nitems;
    }
}

template <bool RAW>
__device__ __forceinline__ void norm_rows(const float* src, bf16_t* dst, float* ssp, int nrows, int gw, int NGW, int lane) {
    for (int row = gw; row < nrows; row += NGW) {
        const f32x4* xr = (const f32x4*)(src + (size_t)row * D) + lane;
        f32x4 v[4]; float ss = 0.f;
#pragma unroll
        for (int j = 0; j < 4; ++j) { v[j] = xr[64 * j]; ss += (v[j][0] * v[j][0] + v[j][1] * v[j][1]) + (v[j][2] * v[j][2] + v[j][3] * v[j][3]); }
        ss = wave_sum(ss, lane);
        const float rstd = RAW ? 1.0f : 1.0f / sqrtf(ss * (1.0f / D) + 1e-6f);
        u32x2* o8 = (u32x2*)(dst + (size_t)row * D) + lane;
#pragma unroll
        for (int j = 0; j < 4; ++j) { v[j] = v[j] * rstd; u32x2 w; w.x = pk2(v[j][0], v[j][1]); w.y = pk2(v[j][2], v[j][3]); o8[64 * j] = w; }
        if (RAW && lane < 16) ssp[(size_t)row * 16 + lane] = (lane == 0) ? ss : 0.f;
    }
}
__device__ __forceinline__ void logf_rows(const bf16_t* HB, const float* ssp, LAS const float* wf, const float* bf, float* logf, int gw, int NGW, int lane) {
    const int rbase = (NGW == 2048) ? (gw >> 8) * 2048 + (gw & 255) : gw, rstep = (NGW == 2048) ? 256 : NGW, rend = (NGW == 2048) ? (gw >> 8) * 2048 + 2048 : M;
    for (int row0 = rbase; row0 < rend; row0 += 4 * rstep) {
        u32x4 hv[4][2]; float rsv[4];
#pragma unroll
        for (int r = 0; r < 4; ++r) { const int row = row0 + r * rstep; const int rr = row < rend ? row : rbase; const u32x4* hp = (const u32x4*)(HB + (size_t)rr * D + lane * 16); hv[r][0] = hp[0]; hv[r][1] = hp[1]; rsv[r] = pg8::row_rstd(ssp, rr); }
#pragma unroll
        for (int r = 0; r < 4; ++r) {
            const int row = row0 + r * rstep;
            f32x4 x[4]; pg8::unpack8(hv[r][0], x[0], x[1]); pg8::unpack8(hv[r][1], x[2], x[3]);
            float a[8];
#pragma unroll
            for (int i = 0; i < 8; ++i) a[i] = 0.f;
#pragma unroll
            for (int e = 0; e < 16; ++e) { const LAS f32x4* wp = (const LAS f32x4*)(wf + (e * 64 + lane) * 8); const f32x4 w0 = wp[0], w1 = wp[1]; const float xv = x[e >> 2][e & 3];
                a[0] += xv * w0[0]; a[1] += xv * w0[1]; a[2] += xv * w0[2]; a[3] += xv * w0[3]; a[4] += xv * w1[0]; a[5] += xv * w1[1]; a[6] += xv * w1[2]; a[7] += xv * w1[3]; }
            float b4[4], b2[2], b1;
            { const bool hi_ = (lane & 32) != 0;
#pragma unroll
              for (int i = 0; i < 4; ++i) { const float snd = hi_ ? a[i] : a[i + 4]; const float kp = hi_ ? a[i + 4] : a[i]; b4[i] = kp + pg8::shx(snd, lane, 32); } }
            { const bool hi_ = (lane & 16) != 0;
#pragma unroll
              for (int i = 0; i < 2; ++i) { const float snd = hi_ ? b4[i] : b4[i + 2]; const float kp = hi_ ? b4[i + 2] : b4[i]; b2[i] = kp + pg8::shx(snd, lane, 16); } }
            { const bool hi_ = (lane & 8) != 0; const float snd = hi_ ? b2[0] : b2[1]; const float kp = hi_ ? b2[1] : b2[0]; b1 = kp + pg8::shx(snd, lane, 8); }
            b1 += pg8::shx(b1, lane, 4); b1 += pg8::shx(b1, lane, 2); b1 += pg8::shx(b1, lane, 1);
            if ((lane & 7) == 0 && row < rend) { const int hh = lane >> 3; const float xx = b1 * rsv[r] + bf[hh]; logf[(size_t)row * 8 + hh] = fminf(xx, 0.f) - log1pf(expf(-fabsf(xx))); }
        }
    }
}
constexpr int LDS_CUM = 81920;
__device__ __forceinline__ void block_cumsum(LAS unsigned char* lds, const float* logf, int b, int h, int tid, int lane, int wave) {
    LAS float* cl = (LAS float*)(lds + LDS_CUM); LAS float* wt = (LAS float*)(lds + LDS_CUM + 8192);
    __syncthreads();
    const float* src = logf + ((size_t)b * T + 4 * tid) * 8 + h;
    const float s0 = src[0], s1 = s0 + src[8], s2 = s1 + src[16], s3 = s2 + src[24];
    float inc = s3;
#pragma unroll
    for (int o = 1; o < 64; o <<= 1) { const float y = pg8::shup(inc, lane, o); if (lane >= o) inc += y; }
    if (lane == 63) wt[wave] = inc;
    __syncthreads();
    float pre = 0.f;
#pragma unroll
    for (int w = 0; w < 8; ++w) { const float x = wt[w]; if (w < wave) pre += x; }
    const float base = pre + inc - s3;
    *(LAS f32x4*)(cl + 4 * tid) = (f32x4){(base + s0) * LOG2E, (base + s1) * LOG2E, (base + s2) * LOG2E, (base + s3) * LOG2E};
    __syncthreads();
}

__device__ __forceinline__ int crow(int r, int hi) { return (r & 3) + 8 * (r >> 2) + 4 * hi; }
template <int HD, bool FOX, int TK, bool SEQ = false>
__device__ __forceinline__ void attn_unit(LAS unsigned char* lds, const bf16_t* Qb, int ldq, const bf16_t* Kb, const bf16_t* Vb, int ldk, bf16_t* Ob, int nkt, int tband, const LAS float* cp, int q0, const float* qgain, const float* kgain) {
    constexpr int KS = HD / 16, DB = HD / 32, NCH = HD / 64, KP = HD * 2 + 16, KSUB = 64 * KP, KBUF = TK * KSUB, VSUB = DB * 4096, VBUF = TK * VSUB;
    constexpr int NBUF = SEQ ? 1 : 2, OFF_K = 0, OFF_V = NBUF * KBUF, OFF_WS = OFF_V + NBUF * VBUF;
    static_assert(OFF_WS + 2048 <= (FOX ? 81920 : 147392), "attention LDS map");
    int tid_ = threadIdx.x; asm volatile("" : "+v"(tid_));
    const int tid = tid_, lane = tid & 63, wid = __builtin_amdgcn_readfirstlane(tid >> 6), r32 = lane & 31, hi = lane >> 5;
    LAS float* wsf = (LAS float*)(lds + OFF_WS) + wid * 64;
    const float cq = FOX ? cp[q0 + wid * 32 + r32] : 0.f;
    const int skey = tid >> 3, sch = tid & 7;
    u32x4 kreg[TK * NCH], vreg[TK * NCH];
    f32x4 kg0[NCH], kg1[NCH];
    if (!FOX) {
#pragma unroll
        for (int i = 0; i < NCH; ++i) { kg0[i] = *(const f32x4*)(kgain + (sch + 8 * i) * 8); kg1[i] = *(const f32x4*)(kgain + (sch + 8 * i) * 8 + 4); }
    }
#define ATT_LOAD(T_) do { _Pragma("unroll") for (int s_ = 0; s_ < TK; ++s_) _Pragma("unroll") for (int i_ = 0; i_ < NCH; ++i_) { const size_t go_ = (size_t)(((T_) * TK + s_) * 64 + skey) * ldk + (sch + 8 * i_) * 8; \
        kreg[s_ * NCH + i_] = *(const u32x4*)(Kb + go_); vreg[s_ * NCH + i_] = *(const u32x4*)(Vb + go_); } } while (0)
#define ATT_STORE(buf) do { _Pragma("unroll") for (int s_ = 0; s_ < TK; ++s_) { \
        if (!FOX) { float ss_ = 0.f; f32x4 a_[NCH][2]; _Pragma("unroll") for (int i_ = 0; i_ < NCH; ++i_) { pg8::unpack8(kreg[s_ * NCH + i_], a_[i_][0], a_[i_][1]); \
              _Pragma("unroll") for (int h_ = 0; h_ < 2; ++h_) ss_ += (a_[i_][h_][0] * a_[i_][h_][0] + a_[i_][h_][1] * a_[i_][h_][1]) + (a_[i_][h_][2] * a_[i_][h_][2] + a_[i_][h_][3] * a_[i_][h_][3]); } \
            ss_ += pg8::shx(ss_, lane, 1); ss_ += pg8::shx(ss_, lane, 2); ss_ += pg8::shx(ss_, lane, 4); const float rs_ = 1.0f / sqrtf(ss_ * (1.0f / HD) + 1e-6f); \
            _Pragma("unroll") for (int i_ = 0; i_ < NCH; ++i_) kreg[s_ * NCH + i_] = pg8::pack8(a_[i_][0] * rs_ * kg0[i_], a_[i_][1] * rs_ * kg1[i_]); } \
        _Pragma("unroll") for (int i_ = 0; i_ < NCH; ++i_) { const int c_ = sch + 8 * i_; \
            *(LAS u32x4*)(lds + OFF_K + (buf) * KBUF + s_ * KSUB + skey * KP + c_ * 16) = kreg[s_ * NCH + i_]; \
            *(LAS u32x4*)(lds + OFF_V + (buf) * VBUF + s_ * VSUB + (c_ >> 2) * 4096 + (skey >> 3) * 512 + (skey & 7) * 64 + (c_ & 3) * 16) = vreg[s_ * NCH + i_]; } } } while (0)
    float mrun = 0.f, lrun = 0.f;
    f32x16 o[DB];
#pragma unroll
    for (int d = 0; d < DB; ++d)
#pragma unroll
        for (int r = 0; r < 16; ++r) o[d][r] = 0.f;
    const int nst = nkt / TK;
    ATT_LOAD(nst - 1);
    bf16x8 qr[KS];
    { const bf16_t* qrow = Qb + (size_t)(wid * 32 + r32) * ldq + hi * 8;
#pragma unroll
      for (int ks = 0; ks < KS; ++ks) qr[ks] = *(const bf16x8*)(qrow + ks * 16);
      if (!FOX) {
          float ss = 0.f;
#pragma unroll
          for (int ks = 0; ks < KS; ++ks)
#pragma unroll
              for (int e = 0; e < 8; ++e) { const float x = __uint_as_float(((unsigned)(unsigned short)qr[ks][e]) << 16); ss += x * x; }
          ss += pg8::shx(ss, lane, 32);
          const float rs = MSCALE / sqrtf(ss * (1.0f / HD) + 1e-6f);
#pragma unroll
          for (int ks = 0; ks < KS; ++ks) { const f32x4 g0 = *(const f32x4*)(qgain + ks * 16 + hi * 8), g1 = *(const f32x4*)(qgain + ks * 16 + hi * 8 + 4); u32x4 w;
              float x[8];
#pragma unroll
              for (int e = 0; e < 8; ++e) x[e] = __uint_as_float(((unsigned)(unsigned short)qr[ks][e]) << 16) * rs * (e < 4 ? g0[e & 3] : g1[e & 3]);
              w.x = pk2(x[0], x[1]); w.y = pk2(x[2], x[3]); w.z = pk2(x[4], x[5]); w.w = pk2(x[6], x[7]); qr[ks] = __builtin_bit_cast(bf16x8, w); }
      } }
    ATT_STORE(0);
    __syncthreads();
    const int dsub = tband + (wid >> 1);
    const int vlane = ((lane >> 4) & 1) * 32 + (lane & 3) * 8 + (4 * hi + ((lane & 15) >> 2)) * 64;
    for (int it = 0; it < nst; ++it) {
        const int T_ = nst - 1 - it, cur = it & 1, jlo = T_ * TK;
        if (!SEQ && it + 1 < nst) ATT_LOAD(T_ - 1);
        const bool active = !FOX || jlo <= dsub;
        f32x16 pA0, pA1, pB0, pB1;
        bool first = false; bool actB = false;
        for (int sq = 0; sq < (SEQ ? TK : 1); ++sq) {
        if (active) {
            first = FOX ? (dsub < jlo + TK) : (it == 0 && sq == 0);
            const float base = first ? cq : cq - mrun;
#define ATT_QK(S, P0, P1) do { \
                if (!FOX || jlo + (S) <= dsub) { \
                    if (FOX) { const LAS float* ckp = cp + (jlo + (S)) * 64 + 4 * hi; \
                        _Pragma("unroll") for (int g = 0; g < 4; ++g) { const f32x4 a = *(const LAS f32x4*)(ckp + 8 * g), b = *(const LAS f32x4*)(ckp + 32 + 8 * g); \
                            _Pragma("unroll") for (int e = 0; e < 4; ++e) { P0[4 * g + e] = base - a[e]; P1[4 * g + e] = base - b[e]; } } \
                    } else { _Pragma("unroll") for (int r = 0; r < 16; ++r) { P0[r] = base; P1[r] = base; } } \
                    const LAS unsigned char* kb = lds + OFF_K + cur * KBUF + (S) * KSUB + r32 * KP + hi * 16; \
                    _Pragma("unroll") for (int ks = 0; ks < KS; ++ks) { const bf16x8 b0 = *(const LAS bf16x8*)(kb + ks * 32), b1 = *(const LAS bf16x8*)(kb + 32 * KP + ks * 32); \
                        P0 = __builtin_amdgcn_mfma_f32_32x32x16_bf16(b0, qr[ks], P0, 0, 0, 0); P1 = __builtin_amdgcn_mfma_f32_32x32x16_bf16(b1, qr[ks], P1, 0, 0, 0); } \
                    if (FOX && jlo + (S) == dsub) { const int qrel = 32 * (wid & 1) + r32; \
                        _Pragma("unroll") for (int r = 0; r < 16; ++r) { const int kv = crow(r, hi); if (kv > qrel) P0[r] = -INFINITY; if (kv + 32 > qrel) P1[r] = -INFINITY; } } \
                } } while (0)
            actB = !SEQ && (TK > 1) && (!FOX || jlo + 1 <= dsub);
            ATT_QK(sq, pA0, pA1);
            if (!SEQ && TK > 1) { __builtin_amdgcn_sched_barrier(0); ATT_QK(1, pB0, pB1); }
        }
        if (active) {
            float rm = fmaxf(pA0[0], pA1[0]);
#pragma unroll
            for (int r = 1; r < 16; ++r) rm = fmaxf(fmaxf(rm, pA0[r]), pA1[r]);
            if (actB) {
#pragma unroll
                for (int r = 0; r < 16; ++r) rm = fmaxf(fmaxf(rm, pB0[r]), pB1[r]);
            }
            rm = fmaxf(rm, pg8::shx(rm, lane, 32));
            if (first) {
                mrun = rm;
#pragma unroll
                for (int r = 0; r < 16; ++r) { pA0[r] -= rm; pA1[r] -= rm; }
                if (actB) {
#pragma unroll
                    for (int r = 0; r < 16; ++r) { pB0[r] -= rm; pB1[r] -= rm; } }
            } else if (__any(rm > 0.f)) {
                const float dl = fmaxf(rm, 0.f); const float al = __builtin_amdgcn_exp2f(-dl); lrun *= al; mrun += dl;
#pragma unroll
                for (int r = 0; r < 16; ++r) { pA0[r] -= dl; pA1[r] -= dl; }
                if (actB) {
#pragma unroll
                    for (int r = 0; r < 16; ++r) { pB0[r] -= dl; pB1[r] -= dl; } }
                if (hi == 0) wsf[r32] = al;
                asm volatile("s_waitcnt lgkmcnt(0)" ::: "memory");
#pragma unroll
                for (int g = 0; g < 4; ++g) { const f32x4 a = *(const LAS f32x4*)(wsf + 8 * g + 4 * hi);
#pragma unroll
                    for (int d = 0; d < DB; ++d)
#pragma unroll
                        for (int e = 0; e < 4; ++e) o[d][4 * g + e] *= a[e]; }
            }
#define ATT_PV(S, P0, P1) do { \
                if (!FOX || jlo + (S) <= dsub) { \
                    float sacc = 0.f; \
                    _Pragma("unroll") for (int r = 0; r < 16; ++r) { P0[r] = __builtin_amdgcn_exp2f(P0[r]); P1[r] = __builtin_amdgcn_exp2f(P1[r]); sacc += P0[r] + P1[r]; } \
                    lrun += sacc; \
                    bf16x8 pw[4]; \
                    _Pragma("unroll") for (int j = 0; j < 2; ++j) { u32x4 w0, w1; \
                        w0.x = pk2(P0[8 * j + 0], P0[8 * j + 1]); w0.y = pk2(P0[8 * j + 2], P0[8 * j + 3]); w0.z = pk2(P0[8 * j + 4], P0[8 * j + 5]); w0.w = pk2(P0[8 * j + 6], P0[8 * j + 7]); \
                        w1.x = pk2(P1[8 * j + 0], P1[8 * j + 1]); w1.y = pk2(P1[8 * j + 2], P1[8 * j + 3]); w1.z = pk2(P1[8 * j + 4], P1[8 * j + 5]); w1.w = pk2(P1[8 * j + 6], P1[8 * j + 7]); \
                        pw[j] = __builtin_bit_cast(bf16x8, w0); pw[2 + j] = __builtin_bit_cast(bf16x8, w1); } \
                    const LAS unsigned char* vb = lds + OFF_V + cur * VBUF + (S) * VSUB + vlane; \
                    _Pragma("unroll") for (int d = 0; d < DB; ++d) \
                        _Pragma("unroll") for (int j = 0; j < 4; ++j) { \
                            const v4i16_t lo = __builtin_amdgcn_ds_read_tr16_b64_v4i16((LAS v4i16_t*)(vb + d * 4096 + j * 1024)); \
                            const v4i16_t hh = __builtin_amdgcn_ds_read_tr16_b64_v4i16((LAS v4i16_t*)(vb + d * 4096 + j * 1024 + 512)); \
                            const bf16x8 vf = (bf16x8){lo[0], lo[1], lo[2], lo[3], hh[0], hh[1], hh[2], hh[3]}; \
                            o[d] = __builtin_amdgcn_mfma_f32_32x32x16_bf16(pw[j], vf, o[d], 0, 0, 0); } \
                } } while (0)
            ATT_PV(sq, pA0, pA1);
            if (!SEQ && TK > 1) { __builtin_amdgcn_sched_barrier(0); ATT_PV(1, pB0, pB1); }
#undef ATT_QK
#undef ATT_PV
        }
        }
        if (!SEQ && it + 1 < nst) ATT_STORE(cur ^ 1);
        __syncthreads();
    }
#undef ATT_LOAD
#undef ATT_STORE
    lrun += pg8::shx(lrun, lane, 32);
    if (hi == 0) wsf[32 + r32] = lrun;
    asm volatile("s_waitcnt lgkmcnt(0)" ::: "memory");
    LAS bf16_t* stg = (LAS bf16_t*)(lds + (SEQ ? 0 : OFF_WS + 2048) + wid * (32 * (HD + 8) * 2));
    static_assert((SEQ ? 0 : OFF_WS + 2048) + 8 * 32 * (HD + 8) * 2 <= (SEQ ? KBUF : (FOX ? 81920 : 147392)), "attention LDS map (O stage)");
#pragma unroll
    for (int g = 0; g < 4; ++g) { const f32x4 lv = *(const LAS f32x4*)(wsf + 32 + 8 * g + 4 * hi);
#pragma unroll
        for (int e = 0; e < 4; ++e) { const float il = 1.0f / lv[e]; const int rr = crow(4 * g + e, hi);
#pragma unroll
            for (int d = 0; d < DB; ++d) stg[rr * (HD + 8) + d * 32 + r32] = (bf16_t)(pk2(o[d][4 * g + e] * il, 0.f) & 0xffffu); } }
    asm volatile("s_waitcnt lgkmcnt(0)" ::: "memory");
    constexpr int CPR = HD / 8;
#pragma unroll
    for (int i = 0; i < (32 * CPR) / 64; ++i) { const int idx = i * 64 + lane, row = idx / CPR, ch = idx % CPR;
        const u32x4 v = *(const LAS u32x4*)(stg + row * (HD + 8) + ch * 8);
        *(u32x4*)(Ob + (size_t)(wid * 32 + row) * ldq + ch * 8) = v; }
    if (SEQ) __syncthreads();
}

#define XB_TMO      128
#define XB_XCNT(j)  (256  + 64 * (j))
#define XB_XSUB(j)  (1280 + 64 * (j))
#define XB_XGEN(j)  (2304 + 64 * (j))
#define XB_TOP      3328
#define XB_TOPGEN   3392
#define XCD_BAR_WORDS 3456
#define XB_SPIN_CAP (1u << 18)

__device__ __forceinline__ unsigned xb_ld(unsigned* p)              { return __hip_atomic_load(p, __ATOMIC_RELAXED, __HIP_MEMORY_SCOPE_AGENT); }
__device__ __forceinline__ unsigned xb_add(unsigned* p, unsigned v) { return __hip_atomic_fetch_add(p, v, __ATOMIC_RELAXED, __HIP_MEMORY_SCOPE_AGENT); }
__device__ __forceinline__ unsigned xb_xcc_id() { return (unsigned)__builtin_amdgcn_s_getreg((3 << 11) | 20) & 0xFu; }
#define XB_SPIN(cond, bar) do { unsigned _sp = 0; while (cond) { __builtin_amdgcn_s_sleep(1); \
    if ((++_sp & 255u) == 0u) { if (xb_ld(&(bar)[XB_TMO])) break; if (_sp > XB_SPIN_CAP) { atomicAdd(&(bar)[XB_TMO], 1u); break; } } } } while (0)

struct XcdBarrier {
    unsigned* bar; unsigned x;
    volatile LAS unsigned* st;
};

__device__ __forceinline__ XcdBarrier xcd_barrier_post(unsigned* bar, volatile LAS unsigned* st) {
    XcdBarrier b; b.bar = bar; b.x = xb_xcc_id(); b.st = st;
    if (threadIdx.x == 0) (void)xb_add(&bar[XB_XCNT(b.x)], 1u);
    return b;
}
__device__ __forceinline__ void xcd_barrier_complete(unsigned* bar, unsigned x, unsigned& nloc, unsigned& nx) {
    const unsigned G = gridDim.x * gridDim.y * gridDim.z;
    unsigned sum, cnt, mine, sp = 0u;
    for (;;) {
        sum = 0u; cnt = 0u; mine = 0u;
#pragma unroll
        for (unsigned j = 0; j < 16; ++j) { const unsigned c = xb_ld(&bar[XB_XCNT(j)]); sum += c; cnt += (c > 0u) ? 1u : 0u; mine = (j == x) ? c : mine; }
        if (sum == G) break;
        __builtin_amdgcn_s_sleep(1);
        if ((++sp & 255u) == 0u) { if (xb_ld(&bar[XB_TMO])) break; if (sp > XB_SPIN_CAP) { atomicAdd(&bar[XB_TMO], 1u); break; } }
    }
    nloc = mine > 0u ? mine : 1u; nx = cnt > 0u ? cnt : 1u;
}

__device__ __forceinline__ void xcd_barrier(const XcdBarrier& b) {
    asm volatile("s_waitcnt vmcnt(0)" ::: "memory");
    __syncthreads();
    if (threadIdx.x == 0) {
        unsigned* bar = b.bar;
        __builtin_amdgcn_s_waitcnt(0);
        unsigned nloc = b.st[0], nx = b.st[1];
        if (nloc == 0u) { xcd_barrier_complete(bar, b.x, nloc, nx); b.st[0] = nloc; b.st[1] = nx; }
        const unsigned old = xb_add(&bar[XB_XSUB(b.x)], 1u);
        const unsigned gen = old / nloc;
        if (old + 1u == (gen + 1u) * nloc) {
            __builtin_amdgcn_fence(__ATOMIC_RELEASE, "agent");
            asm volatile("s_waitcnt vmcnt(0)" ::: "memory");
            const unsigned og = xb_add(&bar[XB_TOP], 1u);
            const unsigned tg = og / nx;
            if (og + 1u == (tg + 1u) * nx) xb_add(&bar[XB_TOPGEN], 1u);
            else XB_SPIN(xb_ld(&bar[XB_TOPGEN]) == tg, bar);
            __builtin_amdgcn_fence(__ATOMIC_ACQUIRE, "agent");
            xb_add(&bar[XB_XGEN(b.x)], 1u);
            asm volatile("s_waitcnt vmcnt(0)" ::: "memory");
        } else {
            XB_SPIN(xb_ld(&bar[XB_XGEN(b.x)]) == gen, bar);
            __builtin_amdgcn_fence(__ATOMIC_ACQUIRE, "agent");
            asm volatile("s_waitcnt vmcnt(0)" ::: "memory");
        }
    }
    __syncthreads();
}

#define XL_SUB(j)  (4096 + 64 * (j))
#define XL_GEN(j)  (5120 + 64 * (j))
#define XL_BAD     6400
#define XL_MAP     6464
__device__ __forceinline__ void xcd_local_barrier(const XcdBarrier& b) {
    asm volatile("s_waitcnt vmcnt(0)" ::: "memory");
    __syncthreads();
    if (threadIdx.x == 0) {
        unsigned* bar = b.bar;
        __builtin_amdgcn_s_waitcnt(0);
        const unsigned nloc = b.st[0];
        const unsigned old = xb_add(&bar[XL_SUB(b.x)], 1u);
        const unsigned gen = old / nloc;
        if (old + 1u == (gen + 1u) * nloc) xb_add(&bar[XL_GEN(b.x)], 1u);
        else XB_SPIN(xb_ld(&bar[XL_GEN(b.x)]) == gen, bar);
        __builtin_amdgcn_fence(__ATOMIC_ACQUIRE, "agent");
        asm volatile("s_waitcnt vmcnt(0)" ::: "memory");
    }
    __syncthreads();
}
#ifndef PH_MASK
#define PH_MASK 0xffff
#endif
#define EN(k) (((PH_MASK) >> (k)) & 1)
#ifndef REP_MASK
#define REP_MASK 0
#endif
#define REPS(k) (1 + (((REP_MASK) >> (k)) & 1))
struct Args { const float* in[21]; float* out; unsigned char* ws; int ph_lo, ph_hi; };
constexpr int N_PHASES = 1 + 9 * DEPTH;

__global__ void __launch_bounds__(512, 2) fwd_kernel(Args args) {
    extern __shared__ __attribute__((aligned(16))) unsigned char lds_raw[];
    LAS unsigned char* lds = (LAS unsigned char*)lds_raw;
    const int wave = __builtin_amdgcn_readfirstlane(threadIdx.x >> 6);
    const int G = gridDim.x, bx = blockIdx.x;
    const int vcu = (G % 8 == 0) ? (bx % 8) * (G / 8) + bx / 8 : bx;
    const int gw = vcu * 8 + wave, NGW = G * 8;
    kargp_t kp = (kargp_t)__builtin_amdgcn_kernarg_segment_ptr();
    unsigned char* ws = args.ws;
    bf16_t* Wb = (bf16_t*)(ws + WS_W);
    bf16_t* HB = (bf16_t*)(ws + WS_U);
    bf16_t* KVM = (bf16_t*)(ws + WS_KVM);
    unsigned char* Pr = ws + WS_P;
    const size_t b_own = (size_t)(bx & 7);
#define PB512(off)  ((bf16_t*)(Pr + b_own * PB_STRIDE + (off) - b_own * ((size_t)T * 512 * 2)))
#define PB1024(off) ((bf16_t*)(Pr + b_own * PB_STRIDE + (off) - b_own * ((size_t)T * 1024 * 2)))
#define PB2816(off) ((bf16_t*)(Pr + b_own * PB_STRIDE + (off) - b_own * ((size_t)T * DFF * 2)))
    float* logf = (float*)(ws + WS_LOGF);
    float* ssp = (float*)(ws + WS_SSP);
    cg::grid_group grid = cg::this_grid();
    volatile LAS unsigned* bst = (volatile LAS unsigned*)(lds + (LDS_BYTES - 64));
    if (threadIdx.x < 16) ((LAS unsigned*)(lds + (LDS_BYTES - 64)))[threadIdx.x] = 0u;
    __syncthreads();
    XcdBarrier xbar = xcd_barrier_post((unsigned*)ws, bst);
    if (threadIdx.x == 0) {
        const unsigned prev = atomicCAS((unsigned*)ws + XL_MAP + (bx & 7), 0u, xbar.x + 1u);
        if (prev != 0u && prev != xbar.x + 1u) atomicAdd((unsigned*)ws + XL_BAD, 1u);
    }
    bool use_local = false;
    if (args.ph_hi > 100000) grid.sync();

    for (int ph = args.ph_lo; ph < args.ph_hi; ++ph) {
        asm volatile("" : "+s"(kp));
        int tid_ = threadIdx.x; asm volatile("" : "+v"(tid_));
        const int tid = tid_, lane = tid & 63;
        if (ph == 0) {
            LAS float* scr = (LAS float*)lds + wave * (64 * 65);
            cvt_layer(kp, 0, Wb, scr, gw, NGW, lane, 0, 8);
            for (int l = 0; l < DEPTH; ++l) { const int start = (gw + 5 * l) % NGW;
                for (int it = start; it < 256; it += NGW) cvt_item(KIN(kp, 14) + (size_t)l * D * 1024, D, 1024, 16, (bf16_t*)(ws + WS_WCKV) + (size_t)l * 1024 * D, 0, KIN(kp, 12) + (size_t)l * D, scr, it, lane); }
            for (int i = bx * 512 + tid; i < DEPTH * 8192; i += G * 512) { const int l = i >> 13, j = i & 8191, k = j >> 3, c = j & 7;
                ((float*)(ws + WS_WFIMG))[(size_t)l * 8192 + ((k & 15) * 64 + (k >> 4)) * 8 + c] = KIN(kp, 3)[(size_t)l * D * INW + (size_t)k * INW + 1536 + c] * KIN(kp, 2)[(size_t)l * D + k]; }
            norm_rows<false>(KIN(kp, 1), (bf16_t*)(ws + WS_MEMHAT), nullptr, MROWS, gw, NGW, lane);
            norm_rows<true>(KIN(kp, 0), HB, ssp, M, gw, NGW, lane);
        } else {
            const int l = (ph - 1) / 9, sp = (ph - 1) % 9;
            const bf16_t* wl = Wb + (size_t)l * W_LAYER;
            if (sp == 0) {
#define LOGF_JOB() do { LAS float* wf = (LAS float*)lds; __syncthreads(); \
                        { const f32x4* src = (const f32x4*)((const float*)(ws + WS_WFIMG) + (size_t)l * 8192); \
                          _Pragma("unroll") for (int i = 0; i < 4; ++i) *(LAS f32x4*)(wf + (tid + 512 * i) * 4) = src[tid + 512 * i]; } \
                        __syncthreads(); \
                        logf_rows(HB, ssp, wf, KIN(kp, 4) + l * 8, logf, gw, NGW, lane); \
                        __syncthreads(); } while (0)
                LOGF_JOB();
                { pg8::Gemm g{HB, wl + W_IN, M, NIN, D}; pg8::StaticOrder S; S.init(M, NIN, G, bx);
                  LAS float* lrs = (LAS float*)(lds + LDS_RSTD); pg8::Unit u0; u0.pm = -1; u0.pn = 0; S.next(0, u0);
                  if (tid < 256 && u0.pm >= 0) lrs[tid] = pg8::row_rstd(ssp, u0.pm * 256 + tid);
                  if (tid < 64) { lrs[256 + tid] = KIN(kp, 5)[l * 64 + tid] * pg8::QSCALE; lrs[320 + tid] = KIN(kp, 6)[l * 64 + tid]; }
                  __syncthreads();
                  pg8::EpiIn E{PB512(0), PB1024(0), KIN(kp, 5) + l * 64, KIN(kp, 6) + l * 64, ssp, lrs, u0.pm};
                  for (int rep = 0; rep < REPS(3); ++rep) pg8::gemm_phase<pg8::EpiIn, pg8::StaticOrder, true, true>(lds, g, S, E); }
#undef LOGF_JOB
            } else if (sp == 1) {
                bf16_t* Qb = PB512(P_Q); const bf16_t* Kb = PB512(P_K); const bf16_t* Vb = PB512(P_V);
                for (int rep = 0; rep < REPS(4); ++rep)
                for (int v = vcu; v < 256; v += G) {
                    const int bh = v >> 2, s = v & 3, b = bh >> 3, h = bh & 7;
                    block_cumsum(lds, logf, b, h, tid, lane, wave);
                    for (int half = 0; half < 2; ++half) {
                        const int qb = half ? 7 - s : s;
                        const size_t rb = (size_t)b * T;
                        attn_unit<64, true, 1>(lds, Qb + (rb + qb * 256) * 512 + h * 64, 512, Kb + rb * 512 + h * 64, Vb + rb * 512 + h * 64, 512, (rep + 1 < REPS(4) ? HB : Qb) + (rb + qb * 256) * 512 + h * 64,
                                            4 * (qb + 1), 4 * qb, (const LAS float*)(lds + LDS_CUM), qb * 256, nullptr, nullptr);
                    }
                }
                {
                    const bf16_t* Zb = PB512(P_Z); bf16_t* GBb = PB512(P_GB); const bf16_t* GCb = PB512(P_GC);
                    const float* cw = KIN(kp, 7) + (size_t)l * 3 * 512 + lane * 8;
                    f32x4 w0a = *(const f32x4*)(cw), w0b = *(const f32x4*)(cw + 4), w1a = *(const f32x4*)(cw + 512), w1b = *(const f32x4*)(cw + 516), w2a = *(const f32x4*)(cw + 1024), w2b = *(const f32x4*)(cw + 1028);
                    const int ibase = (NGW == 2048) ? (gw >> 8) * 512 + (gw & 255) : gw, istep = (NGW == 2048) ? 256 : NGW, iend = (NGW == 2048) ? (gw >> 8) * 512 + 512 : M / 4;
                    for (int rep = 0; rep < REPS(11); ++rep)
                    for (int item = ibase; item < iend; item += istep) {
                        const int r0 = item * 4; const size_t eo = (size_t)r0 * 512 + lane * 8;
                        const bool head = (r0 & (T - 1)) == 0;
                        u32x4 zr[6], cr[6], gr[4];
#pragma unroll
                        for (int i = 0; i < 6; ++i) { const size_t o = (head && i < 2) ? eo : eo + (size_t)(i - 2) * 512; zr[i] = *(const u32x4*)(Zb + o); cr[i] = *(const u32x4*)(GCb + o); }
#pragma unroll
                        for (int i = 0; i < 4; ++i) gr[i] = *(const u32x4*)(GBb + eo + i * 512);
                        f32x4 xa[6], xb[6];
#pragma unroll
                        for (int i = 0; i < 6; ++i) { f32x4 za, zb, ca, cb; pg8::unpack8(zr[i], za, zb); pg8::unpack8(cr[i], ca, cb); xa[i] = za * ca; xb[i] = zb * cb;
                            if (head && i < 2) { xa[i] = (f32x4){0.f, 0.f, 0.f, 0.f}; xb[i] = xa[i]; } }
#pragma unroll
                        for (int i = 0; i < 4; ++i) { f32x4 ga, gb2; pg8::unpack8(gr[i], ga, gb2);
                            const f32x4 ya = ga * (w0a * xa[i] + w1a * xa[i + 1] + w2a * xa[i + 2]), yb = gb2 * (w0b * xb[i] + w1b * xb[i + 1] + w2b * xb[i + 2]);
                            *(u32x4*)((rep + 1 < REPS(11) ? HB : GBb) + eo + i * 512) = pg8::pack8(ya, yb); }
                    }
                }
            } else if (sp == 2) {
                pg8::StaticOrder S; S.init(M, D, G, bx);
                pg8::Gemm g{PB512(P_Q), wl + W_UA, M, D, D, PB512(P_GB), 512, 8};
                pg8::EpiGate2 E{PB1024(P_SGA), PB1024(P_SGB), PB1024(P_MRG)};
                for (int rep = 0; rep < REPS(5); ++rep) pg8::gemm_phase<pg8::EpiGate2, pg8::StaticOrder, true, true>(lds, g, S, E);
            } else if (sp == 3 || sp == 6 || sp == 8) {
                const bf16_t* A = (sp == 3) ? PB1024(P_MRG) : (sp == 6) ? PB512(P_QM) : PB2816(P_ACT);
                const bf16_t* Bt = wl + (sp == 3 ? W_O : sp == 6 ? W_CO : W_DN);
                const int K = (sp == 3) ? D : (sp == 6) ? 512 : DFF;
                const float* basef = (l == 0 && sp == 3) ? KIN(kp, 0) : nullptr;
                float* outf = (l == DEPTH - 1 && sp == 8) ? args.out : nullptr;
                pg8::Gemm g{A, Bt, M, D, K}; pg8::StaticOrder S; S.init(M, D, G, bx);
                { pg8::EpiResid E{basef, outf, HB, ssp};
                pg8::gemm_phase<pg8::EpiResid, pg8::StaticOrder, true, true>(lds, g, S, E); }
            } else if (sp == 4) {
                const int GH = G / 2; const bool second = bx >= GH;
                pg8::Gemm g = second ? pg8::Gemm{(const bf16_t*)(ws + WS_MEMHAT), (const bf16_t*)(ws + WS_WCKV), MROWS, 4096, D} : pg8::Gemm{HB, wl + W_CQ, M, 512, D};
                pg8::StaticOrder S; S.init(g.M, g.N, GH, second ? bx - GH : bx);
                pg8::EpiPlain E = second ? pg8::EpiPlain{KVM, 4096, nullptr} : pg8::EpiPlain{PB512(P_QM), 512, ssp};
                if (!second || l == 0) for (int rep = 0; rep < REPS(7); ++rep) pg8::gemm_phase<pg8::EpiPlain, pg8::StaticOrder, true, true>(lds, g, S, E);
                if (second && l >= 1 && l + 1 < DEPTH) cvt_layer(kp, l + 1, Wb + (size_t)(l + 1) * W_LAYER, (LAS float*)lds + wave * (64 * 65), (bx - GH) * 8 + wave, (G - GH) * 8, lane, 0, 6);
            } else if (sp == 5) {
                bf16_t* Qm = PB512(P_QM);
                for (int rep = 0; rep < REPS(8); ++rep)
                for (int v = vcu; v < 256; v += G) {
                    const int b = v >> 5, h = (v >> 3) & 3, qb = v & 7;
                    const bf16_t* Kb = KVM + (size_t)b * MEMT * 4096 + l * 1024 + h * 128;
                    bf16_t* qp = Qm + ((size_t)b * T + qb * 256) * 512 + h * 128;
                    attn_unit<128, false, 4, true>(lds, qp, 512, Kb, Kb + 512, 4096, qp, 4, 0, (const LAS float*)nullptr, 0, KIN(kp, 15) + l * 128, KIN(kp, 16) + l * 128);
                }
            } else {
                pg8::Gemm g{HB, wl + W_GU, M, NGU, D}; pg8::StaticOrder S; S.init(M, NGU, G, bx);
                LAS float* lrs = (LAS float*)(lds + LDS_RSTD); pg8::Unit u0; u0.pm = -1; u0.pn = 0; S.next(0, u0);
                if (tid < 256 && u0.pm >= 0) lrs[tid] = pg8::row_rstd(ssp, u0.pm * 256 + tid);
                __syncthreads();
                pg8::EpiSwiglu E{PB2816(P_ACT), ssp, lrs, u0.pm};
                for (int rep = 0; rep < REPS(9); ++rep) pg8::gemm_phase<pg8::EpiSwiglu, pg8::StaticOrder, true, true>(lds, g, S, E);
                if (l + 1 < DEPTH && bx >= G / 2) { __syncthreads(); cvt_layer(kp, l + 1, Wb + (size_t)(l + 1) * W_LAYER, (LAS float*)lds + wave * (64 * 65), (bx - G / 2) * 8 + wave, (G - G / 2) * 8, lane, l == 0 ? 0 : 6, 8); }
            }
        }
        if (ph + 1 < args.ph_hi) {
            const int l_ = (ph - 1) / 9, sp_ = (ph - 1) % 9;
            const bool global_seam = !use_local || ph == 0 || sp_ == 8 || (l_ == 0 && sp_ == 4);
            if (global_seam) xcd_barrier(xbar); else { xcd_local_barrier(xbar); if (REPS(13) > 1) { xcd_local_barrier(xbar); xcd_local_barrier(xbar); xcd_local_barrier(xbar); xcd_local_barrier(xbar); } }
            if (ph == 0) {
                if (threadIdx.x == 0) { unsigned okc = 0u;
                    for (unsigned j = 0; j < 16; ++j) { const unsigned c = xb_ld((unsigned*)ws + XB_XCNT(j)); okc += (c == 32u) ? 1u : (c == 0u ? 0u : 100u); }
                    bst[2] = (okc == 8u && G == 256 && xb_ld((unsigned*)ws + XL_BAD) == 0u) ? 1u : 0u;
#ifdef PROBE_PLACEMENT
                    { unsigned long long wait = 0ull; if (okc == 8u) wait += 50000ull; const unsigned nb = xb_ld((unsigned*)ws + XL_BAD); if (nb == 0u) wait += 100000ull; else if (nb >= 128u) wait += 200000ull;
                      if (bx == 0) { const unsigned long long t0 = __builtin_amdgcn_s_memrealtime(); while (__builtin_amdgcn_s_memrealtime() - t0 < wait) __builtin_amdgcn_s_sleep(8); } }
#endif
                }
                __syncthreads();
                use_local = bst[2] != 0u;
#ifdef FORCE_GLOBAL_SEAMS
                use_local = false;
#endif
            }
        }
    }
}

#ifndef MK_ONE_LAUNCH
#define MK_ONE_LAUNCH 1
#endif
extern "C" void kernel_launch(void* const* d_in, const int* in_sizes, int n_in, void* d_out, int out_size, void* d_ws, size_t ws_size, hipStream_t stream) {
    static int grid = 0;
    if (grid == 0) {
        if (n_in != 21 || out_size != M * D || ws_size < WS_END) { fprintf(stderr, "kernel_launch: unexpected shapes (n_in %d, out %d, ws %zu)\n", n_in, out_size, ws_size); grid = -1; return; }
        if (hipFuncSetAttribute((const void*)fwd_kernel, hipFuncAttributeMaxDynamicSharedMemorySize, LDS_BYTES) != hipSuccess) { fprintf(stderr, "kernel_launch: hipFuncSetAttribute failed\n"); grid = -1; return; }
        int dev = 0, cus = 0, per_cu = 0;
        hipGetDevice(&dev); hipDeviceGetAttribute(&cus, hipDeviceAttributeMultiprocessorCount, dev);
        hipOccupancyMaxActiveBlocksPerMultiprocessor(&per_cu, (const void*)fwd_kernel, 512, LDS_BYTES);
        (void)hipGetLastError();
        if (per_cu < 1) per_cu = 1;
        grid = cus;
        if (grid != 256) { fprintf(stderr, "kernel_launch: built for a 256-CU device (one workgroup per CU, one batch element per XCC); got %d CUs\n", cus); grid = -1; return; }
    }
    if (grid < 0) return;
    if (hipMemsetAsync(d_ws, 0, 65536, stream) != hipSuccess) { fprintf(stderr, "kernel_launch: memset of the barrier words failed\n"); return; }
    Args a{};
    for (int i = 0; i < 21; ++i) a.in[i] = (const float*)d_in[i];
    a.out = (float*)d_out; a.ws = (unsigned char*)d_ws;
#if MK_ONE_LAUNCH
    a.ph_lo = 0; a.ph_hi = N_PHASES;
    void* kargs[] = {&a};
    hipError_t e = hipLaunchCooperativeKernel((const void*)fwd_kernel, dim3(grid), dim3(512), kargs, LDS_BYTES, stream);
    if (e != hipSuccess) fprintf(stderr, "cooperative launch failed: %s (grid %d)\n", hipGetErrorString(e), grid);
#else
    for (int ph = 0; ph < N_PHASES; ++ph) { a.ph_lo = ph; a.ph_hi = ph + 1; hipLaunchKernelGGL(fwd_kernel, dim3(grid), dim3(512), LDS_BYTES, stream, a); }
#endif
}
```
